# Optimizing an MI355X kernel written in HIP

```python
import math
import jax, jax.numpy as jnp
from jax import lax
import numpy as np

D_MODEL = 2048
BATCH = 1
SEQ = 8192
DEPTH = 2

N_EVEN = (DEPTH + 1) // 2
N_ODD = DEPTH // 2
D_HY = D_MODEL // 2
D_SC = D_MODEL // 2
HY_STREAMS = 3
SC_STREAMS = 3
D_IN = HY_STREAMS * D_HY + SC_STREAMS * D_SC
SHORT_W = 3
FILTER_BANDS = 16
EMB_DIM = 1 + 2 * FILTER_BANDS
FILTER_HIDDEN = 64
DECAY_TARGET = 1e-2
FAST_DECAY_PCT = 0.3
SLOW_DECAY_PCT = 1.5
POOL_WINDOWS = (2, 4, 8, 16)
N_POOL_GROUPS = len(POOL_WINDOWS)
D_POOL_G = D_MODEL // N_POOL_GROUPS
D_FF = 4 * D_MODEL
NORM_EPS = 1e-6

kernel_name = "hybrid_hyena_shortconv_pool_encoder"


def rmsnorm(u, g):
    u32 = u.astype(jnp.float32)
    r = lax.rsqrt(jnp.mean(u32 * u32, axis=-1, keepdims=True) + NORM_EPS)
    return (u32 * r * g.astype(jnp.float32)).astype(u.dtype)


def dwconv3(u, w, b=None):
    up = jnp.pad(u, ((0, 0), (1, 1), (0, 0)))
    y = up[:, :-2] * w[0] + up[:, 1:-1] * w[1] + up[:, 2:] * w[2]
    return y if b is None else y + b


def hyena_filters(L, w1, b1, w2, b2, w3, b3, freq):
    f32 = jnp.float32
    t = jnp.linspace(0.0, 1.0, L, dtype=f32)[:, None]
    w_pos = 2.0 * math.pi * jnp.arange(L, dtype=f32)[:, None] / L
    bands = jnp.linspace(1e-4, FILTER_BANDS - 1, FILTER_BANDS, dtype=f32)[None, :]
    ang = w_pos * bands
    emb = jnp.concatenate([t, jnp.cos(ang), -jnp.sin(ang)], axis=-1)
    fr = freq.astype(f32)
    h = jnp.sin(fr * (emb @ w1.astype(f32) + b1.astype(f32)))
    h = jnp.sin(fr * (h @ w2.astype(f32) + b2.astype(f32)))
    h = h @ w3.astype(f32) + b3.astype(f32)
    max_decay = math.log(DECAY_TARGET) / FAST_DECAY_PCT
    min_decay = math.log(DECAY_TARGET) / SLOW_DECAY_PCT
    deltas = jnp.linspace(min_decay, max_decay, D_HY, dtype=f32)[None, :]
    window = jnp.exp(-t * jnp.abs(deltas))
    return h[:, :D_HY] * window, h[:, D_HY:] * window


def two_sided_fftconv(v, h_fwd, h_bwd, bias):
    L = v.shape[1]
    v32 = v.astype(jnp.float32)
    k = jnp.concatenate([h_fwd, jnp.zeros((1, D_HY), jnp.float32), h_bwd[:0:-1]], axis=0)
    V = jnp.fft.rfft(v32, n=2 * L, axis=1)
    K = jnp.fft.rfft(k, n=2 * L, axis=0)
    y = jnp.fft.irfft(V * K[None], n=2 * L, axis=1)[:, :L]
    return (y + v32 * bias.astype(jnp.float32)).astype(v.dtype)


def hyena_shortconv_mixer(h, w_in, hy_short_w, hy_short_b, f_w1, f_b1, f_w2, f_b2, f_w3, f_b3,
                          freq, hy_bias, sc_conv_w, w_out):
    L = h.shape[1]
    z = h @ w_in
    hy = dwconv3(z[..., :HY_STREAMS * D_HY], hy_short_w, hy_short_b)
    x0, x1, v = jnp.split(hy, HY_STREAMS, axis=-1)
    h_fwd, h_bwd = hyena_filters(L, f_w1, f_b1, f_w2, f_b2, f_w3, f_b3, freq)
    y_a = x0 * two_sided_fftconv(v * x1, h_fwd, h_bwd, hy_bias)
    gb, gc, xv = jnp.split(z[..., HY_STREAMS * D_HY:], SC_STREAMS, axis=-1)
    y_b = gb * dwconv3(gc * xv, sc_conv_w)
    return jnp.concatenate([y_a, y_b], axis=-1) @ w_out


def centred_mean(u, r):
    L = u.shape[1]
    cs = jnp.pad(lax.cumsum(u.astype(jnp.float32), axis=1), ((0, 0), (1, 0), (0, 0)))
    t = jnp.arange(L)
    lo = jnp.maximum(t - r, 0)
    hi = jnp.minimum(t + r + 1, L)
    s = cs[:, hi] - cs[:, lo]
    cnt = (hi - lo).astype(jnp.float32)[None, :, None]
    return (s / cnt).astype(u.dtype)


def pool_mixer(h, pool_w, pool_scale):
    outs = []
    for g, w in enumerate(POOL_WINDOWS):
        u = h[..., g * D_POOL_G:(g + 1) * D_POOL_G]
        d = centred_mean(u, w // 2) - u
        outs.append(d @ pool_w[g])
    return jnp.concatenate(outs, axis=-1) * pool_scale


def setup_inputs(seed: int = 0) -> dict:
    key = jax.random.key(seed)
    ks = jax.random.split(key, 20)
    nrm = lambda k, shape, s: jax.random.normal(k, shape, jnp.float32) * s
    return {
        "x": nrm(ks[0], (BATCH, SEQ, D_MODEL), 1.0),
        "norm_g": 1.0 + nrm(ks[1], (DEPTH, 4, D_MODEL), 0.05),
        "mix_w_in": nrm(ks[2], (N_EVEN, D_MODEL, D_IN), D_MODEL ** -0.5),
        "hy_short_w": nrm(ks[3], (N_EVEN, SHORT_W, HY_STREAMS * D_HY), SHORT_W ** -0.5),
        "hy_short_b": nrm(ks[4], (N_EVEN, HY_STREAMS * D_HY), 0.02),
        "hy_filt_w1": nrm(ks[5], (N_EVEN, EMB_DIM, FILTER_HIDDEN), EMB_DIM ** -0.5),
        "hy_filt_b1": nrm(ks[6], (N_EVEN, FILTER_HIDDEN), 0.02),
        "hy_filt_w2": nrm(ks[7], (N_EVEN, FILTER_HIDDEN, FILTER_HIDDEN), FILTER_HIDDEN ** -0.5),
        "hy_filt_b2": nrm(ks[8], (N_EVEN, FILTER_HIDDEN), 0.02),
        "hy_filt_w3": nrm(ks[9], (N_EVEN, FILTER_HIDDEN, 2 * D_HY), FILTER_HIDDEN ** -0.5),
        "hy_filt_b3": nrm(ks[10], (N_EVEN, 2 * D_HY), 0.02),
        "hy_freq": 1.0 + nrm(ks[11], (N_EVEN, FILTER_HIDDEN), 0.05),
        "hy_bias": nrm(ks[12], (N_EVEN, D_HY), 0.5),
        "sc_conv_w": nrm(ks[13], (N_EVEN, SHORT_W, D_SC), SHORT_W ** -0.5),
        "mix_w_out": nrm(ks[14], (N_EVEN, D_HY + D_SC, D_MODEL), (D_HY + D_SC) ** -0.5),
        "pool_w": nrm(ks[15], (N_ODD, N_POOL_GROUPS, D_POOL_G, D_POOL_G), D_POOL_G ** -0.5),
        "pool_scale": 1.0 + nrm(ks[16], (N_ODD, D_MODEL), 0.1),
        "mlp_w1": nrm(ks[17], (DEPTH, D_MODEL, D_FF), D_MODEL ** -0.5),
        "mlp_w2": nrm(ks[18], (DEPTH, D_FF, D_MODEL), D_FF ** -0.5),
    }


def reference(x, norm_g, mix_w_in, hy_short_w, hy_short_b, hy_filt_w1, hy_filt_b1, hy_filt_w2,
              hy_filt_b2, hy_filt_w3, hy_filt_b3, hy_freq, hy_bias, sc_conv_w, mix_w_out,
              pool_w, pool_scale, mlp_w1, mlp_w2):
    for i in range(DEPTH):
        g = norm_g[i]
        j = i // 2
        h = rmsnorm(x, g[0])
        if i % 2 == 0:
            m = hyena_shortconv_mixer(h, mix_w_in[j], hy_short_w[j], hy_short_b[j],
                                      hy_filt_w1[j], hy_filt_b1[j], hy_filt_w2[j], hy_filt_b2[j],
                                      hy_filt_w3[j], hy_filt_b3[j], hy_freq[j], hy_bias[j],
                                      sc_conv_w[j], mix_w_out[j])
        else:
            m = pool_mixer(h, pool_w[j], pool_scale[j])
        x = x + rmsnorm(m, g[1])
        h = rmsnorm(x, g[2])
        f = jnp.square(jax.nn.relu(h @ mlp_w1[i])) @ mlp_w2[i]
        x = x + rmsnorm(f, g[3])
    return x
```

```cpp
#include <hip/hip_runtime.h>
#include <hip/hip_cooperative_groups.h>
#include <cstdio>
#include <cstdint>
#include <type_traits>
namespace cg = cooperative_groups;


#define LAS __attribute__((address_space(3)))
typedef unsigned short bf16_t;
typedef short bf16x8 __attribute__((ext_vector_type(8)));
typedef float f32x4 __attribute__((ext_vector_type(4)));
typedef float f32x2 __attribute__((ext_vector_type(2)));
typedef unsigned u32x4 __attribute__((ext_vector_type(4)));
typedef unsigned u32x2 __attribute__((ext_vector_type(2)));

constexpr int L = 8192, D = 2048, DIN = 6144, DHY = 1024, DFF = 8192, NFFT = 16384;
constexpr size_t MiB = 1024ull * 1024ull;
constexpr size_t WS_WIN = 0, WS_WOUT = 24 * MiB, WS_W1 = 32 * MiB, WS_W2 = 96 * MiB, WS_WPOOL = 160 * MiB, WS_SMALL = 162 * MiB,
                 WS_ABUF = 166 * MiB, WS_ABUF2 = 198 * MiB, WS_M = 230 * MiB, WS_H = 294 * MiB, WS_END = 422 * MiB;
constexpr int FFT_LDS_BYTES = (NFFT / 64) * 68 * 8;
constexpr int LDS_BYTES = FFT_LDS_BYTES + 64;
constexpr size_t WS_CTL = WS_SMALL + 64 * 1024, CTL_BYTES = 16 * 1024;
constexpr int NPHASE = 16;

__device__ __forceinline__ unsigned pk2(float lo, float hi) { unsigned r; asm volatile("v_cvt_pk_bf16_f32 %0, %1, %2" : "=v"(r) : "v"(lo), "v"(hi)); return r; }
__device__ __forceinline__ float bf_lo(unsigned w) { return __uint_as_float(w << 16); }
__device__ __forceinline__ float bf_hi(unsigned w) { return __uint_as_float(w & 0xffff0000u); }
__device__ __forceinline__ void unpack8(u32x4 w, float* f) { f[0] = bf_lo(w.x); f[1] = bf_hi(w.x); f[2] = bf_lo(w.y); f[3] = bf_hi(w.y); f[4] = bf_lo(w.z); f[5] = bf_hi(w.z); f[6] = bf_lo(w.w); f[7] = bf_hi(w.w); }
__device__ __forceinline__ u32x4 pack8(const float* f) { u32x4 o; o.x = pk2(f[0], f[1]); o.y = pk2(f[2], f[3]); o.z = pk2(f[4], f[5]); o.w = pk2(f[6], f[7]); return o; }
__device__ __forceinline__ float wave_sum(float v) {
#pragma unroll
    for (int o = 1; o < 64; o <<= 1) v += __shfl_xor(v, o);
    return v;
}
__device__ __forceinline__ float sin_rev(float r) { return __builtin_amdgcn_sinf(r); }
__device__ __forceinline__ float cos_rev(float r) { return __builtin_amdgcn_cosf(r); }
#define LDS_WAIT() asm volatile("s_waitcnt lgkmcnt(0)" ::: "memory")

namespace pg8 {
constexpr int BM = 256, BK = 64, HALF = 128, HTB = HALF * BK * 2, STAGE_BYTES = 8 * HTB, NXCD = 8, WGM = 2;
__host__ __device__ __forceinline__ int lds_byte(int r, int c) { const int st = (r >> 4) * 2 + (c >> 5), rr = r & 15, cc = c & 31, ob = rr * 64 + cc * 2; return st * 1024 + (ob ^ (((ob >> 9) & 1) << 5)); }
__host__ __device__ __forceinline__ void stage_rc(int b, int& R, int& C) { const int st = b / 1024, sb = b % 1024, swz = sb ^ (((sb >> 9) & 1) << 5); R = (st >> 1) * 16 + swz / 64; C = (st & 1) * 32 + (swz % 64) / 2; }
__host__ __device__ __forceinline__ int perm32(int rho) { const int n = rho >> 4, i = rho & 15; return 8 * (i >> 2) + 4 * n + (i & 3); }
struct Unit { int pm, pn; };
struct Gemm { const bf16_t* A; const bf16_t* Bt; int M, N, K, lda, ldb, apn_mul; };
struct StaticOrder {
    int nM, nN, nwg, G, c;
    __host__ __device__ void init(int M, int N, int G_, int c_) { nM = M / BM; nN = N / BM; nwg = nM * nN; G = G_; c = c_; }
    __host__ __device__ bool next(int i, Unit& u) const {
        const long Lx = (long)i * G + c; if (Lx >= nwg) return false;
        int wgid = (int)Lx; { const int q = nwg / NXCD, r = nwg % NXCD, xcd = wgid % NXCD, off = wgid / NXCD; wgid = (xcd < r ? xcd * (q + 1) : r * (q + 1) + (xcd - r) * q) + off; }
        const int nig = WGM * nN, gid = wgid / nig, fm = gid * WGM, gsz = (nM - fm) < WGM ? (nM - fm) : WGM;
        u.pm = fm + ((wgid % nig) % gsz); u.pn = (wgid % nig) / gsz; return true;
    }
};

template <bool SQRELU> struct EpiRowScaleBf16 {
    static constexpr bool PERM = true;
    bf16_t* O; int ldc; const float* rs;
    __device__ __forceinline__ void operator()(const f32x4 (&acc)[2][2][4][2], const Unit& u, int wr, int wc, int fr, int fq) const {
        const int row0 = u.pm * BM + wr * 64 + fr, col0 = u.pn * BM + wc * 32 + 8 * fq;
#pragma unroll
        for (int ai = 0; ai < 2; ++ai)
#pragma unroll
            for (int m = 0; m < 4; ++m) { const int row = row0 + ai * HALF + m * 16; const float r = rs[row]; bf16_t* rowp = O + (size_t)row * ldc + col0;
#pragma unroll
                for (int bj = 0; bj < 2; ++bj) { f32x4 v0 = acc[ai][bj][m][0] * r, v1 = acc[ai][bj][m][1] * r;
                    if (SQRELU) {
#pragma unroll
                        for (int j = 0; j < 4; ++j) { float a = fmaxf(v0[j], 0.f), b = fmaxf(v1[j], 0.f); v0[j] = a * a; v1[j] = b * b; } }
                    u32x4 w; w.x = pk2(v0[0], v0[1]); w.y = pk2(v0[2], v0[3]); w.z = pk2(v1[0], v1[1]); w.w = pk2(v1[2], v1[3]);
                    *(u32x4*)(rowp + bj * HALF) = w; } }
    }
};
struct EpiF32SS {
    static constexpr bool PERM = false;
    float* C; int ldc; const float* cs; float* sspart;
    __device__ __forceinline__ void operator()(const f32x4 (&acc)[2][2][4][2], const Unit& u, int wr, int wc, int fr, int fq) const {
        const int row0 = u.pm * BM + wr * 64 + fr, col0 = u.pn * BM + wc * 32 + 4 * fq;
        f32x4 sv[2][2];
#pragma unroll
        for (int bj = 0; bj < 2; ++bj)
#pragma unroll
            for (int n = 0; n < 2; ++n) sv[bj][n] = cs ? *(const f32x4*)(cs + col0 + bj * HALF + n * 16) : (f32x4){1.f, 1.f, 1.f, 1.f};
#pragma unroll
        for (int ai = 0; ai < 2; ++ai)
#pragma unroll
            for (int m = 0; m < 4; ++m) { const int row = row0 + ai * HALF + m * 16; float* rowp = C + (size_t)row * ldc + col0; float s = 0.f;
#pragma unroll
                for (int bj = 0; bj < 2; ++bj)
#pragma unroll
                    for (int n = 0; n < 2; ++n) { const f32x4 v = acc[ai][bj][m][n] * sv[bj][n]; *(f32x4*)(rowp + bj * HALF + n * 16) = v; s += (v[0] * v[0] + v[1] * v[1]) + (v[2] * v[2] + v[3] * v[3]); }
                s += __shfl_xor(s, 16); s += __shfl_xor(s, 32);
                if (fq == 0) sspart[(size_t)row * 32 + u.pn * 4 + wc] = s; }
    }
};

template <class Epi, bool ALIGN_EPI = false, bool FUSED = false>
__device__ __forceinline__ bool gemm_phase(LAS unsigned char* lds, const Gemm g, const StaticOrder& S, const Epi& E, f32x4 (&acc)[2][2][4][2], Unit& cur) {
    const int tid = threadIdx.x, wid = __builtin_amdgcn_readfirstlane(tid >> 6), lane = tid & 63, wr = wid >> 2, wc = wid & 3, fr = lane & 15, fq = lane >> 4;
    const int K = g.K, nt = K / BK;
    unsigned voffA[2], voffB[2];
#pragma unroll
    for (int i = 0; i < 2; ++i) { int R, C; stage_rc(tid * 16 + i * 8192, R, C); const int Rb = Epi::PERM ? ((R & ~31) + perm32(R & 31)) : R;
        voffA[i] = (unsigned)(R * g.lda + C) * 2u; voffB[i] = (unsigned)(Rb * g.ldb + C) * 2u; }
    const size_t kstep = (size_t)(BK * 2);
    const size_t hstepA = (size_t)HALF * g.lda * 2, hstepB = (size_t)HALF * g.ldb * 2;
    const size_t tstepA = 2 * hstepA, tstepB = 2 * hstepB;
    const unsigned ldsw = (unsigned)wid * 1024u;
    const int aoff = lds_byte(wr * 64 + fr, fq * 8), boff = lds_byte(wc * 32 + fr, fq * 8);
#define PG8_SA(b, h) (((b) * 2 + (h)) * HTB)
#define PG8_SB(b, h) ((4 + (b) * 2 + (h)) * HTB)
#define PG8_STAGE(bufoff, gbase, voff) do { _Pragma("unroll") for (int _i = 0; _i < 2; ++_i) \
        __builtin_amdgcn_global_load_lds((const unsigned*)((const char*)(gbase) + (voff)[_i]), (LAS unsigned*)(lds + (bufoff) + ldsw + _i * 8192), 16, 0, 0); } while (0)
#define PG8_LDA(dst, b, h) do { _Pragma("unroll") for (int m = 0; m < 4; ++m) _Pragma("unroll") for (int k = 0; k < 2; ++k) dst[m][k] = *(const LAS bf16x8*)(lds + PG8_SA(b, h) + aoff + m * 2048 + k * 1024); } while (0)
#define PG8_LDB(dst, b, h) do { _Pragma("unroll") for (int n = 0; n < 2; ++n) _Pragma("unroll") for (int k = 0; k < 2; ++k) dst[n][k] = *(const LAS bf16x8*)(lds + PG8_SB(b, h) + boff + n * 2048 + k * 1024); } while (0)
#define PG8_MMA(ai, bj, At, Bt) do { __builtin_amdgcn_s_setprio(1); _Pragma("unroll") for (int m = 0; m < 4; ++m) _Pragma("unroll") for (int n = 0; n < 2; ++n) _Pragma("unroll") for (int k = 0; k < 2; ++k) \
        acc[ai][bj][m][n] = __builtin_amdgcn_mfma_f32_16x16x32_bf16(Bt[n][k], At[m][k], acc[ai][bj][m][n], 0, 0, 0); __builtin_amdgcn_s_setprio(0); } while (0)
#define PG8_WAIT_V(n) asm volatile("s_waitcnt vmcnt(" #n ")" ::: "memory")
#define PG8_WAIT_L(n) asm volatile("s_waitcnt lgkmcnt(" #n ")" ::: "memory")
#define PG8_BAR __builtin_amdgcn_s_barrier()
#define PG8_SCHED __builtin_amdgcn_sched_barrier(0)
    Unit nxt; int ui = 0;
    if (!S.next(0, cur)) return false;
#pragma unroll
    for (int a = 0; a < 2; ++a)
#pragma unroll
        for (int b = 0; b < 2; ++b)
#pragma unroll
            for (int m = 0; m < 4; ++m)
#pragma unroll
                for (int n = 0; n < 2; ++n) acc[a][b][m][n] = (f32x4){0.f, 0.f, 0.f, 0.f};
    bf16x8 At[4][2], B0[2][2], B1[2][2];
    const char* cA = (const char*)g.A + (size_t)cur.pm * tstepA + (size_t)((cur.pn >> 1) * g.apn_mul) * 2; const char* cB = (const char*)g.Bt + (size_t)cur.pn * tstepB;
    PG8_STAGE(PG8_SB(0, 0), cB, voffB); PG8_STAGE(PG8_SB(0, 1), cB + hstepB, voffB); PG8_STAGE(PG8_SA(0, 0), cA, voffA); PG8_STAGE(PG8_SA(0, 1), cA + hstepA, voffA);
    if (wr == 1) PG8_BAR;
    PG8_WAIT_V(2); PG8_BAR;
    PG8_STAGE(PG8_SB(1, 0), cB + kstep, voffB); PG8_STAGE(PG8_SA(1, 0), cA + kstep, voffA); PG8_STAGE(PG8_SB(1, 1), cB + hstepB + kstep, voffB);
    PG8_WAIT_V(6); PG8_BAR;
    for (;;) {
        const bool has_next = S.next(ui + 1, nxt);
        const char* nA = has_next ? (const char*)g.A + (size_t)nxt.pm * tstepA + (size_t)((nxt.pn >> 1) * g.apn_mul) * 2 : cA; const char* nB = has_next ? (const char*)g.Bt + (size_t)nxt.pn * tstepB : cB;
        for (int t = 0; t < nt; t += 2) {
            const bool last = (t == nt - 2);
            const char* a1 = cA + (size_t)(t + 1) * kstep;
            const char* a2 = last ? nA : cA + (size_t)(t + 2) * kstep; const char* b2 = last ? nB : cB + (size_t)(t + 2) * kstep;
            const char* a3 = a2 + kstep; const char* b3 = b2 + kstep;
            PG8_LDB(B0, 0, 0); PG8_LDB(B1, 0, 1); PG8_SCHED; PG8_LDA(At, 0, 0); PG8_STAGE(PG8_SA(1, 1), a1 + hstepA, voffA);
            PG8_WAIT_V(8); PG8_WAIT_L(0); PG8_BAR; PG8_MMA(0, 0, At, B0); PG8_MMA(0, 1, At, B1); PG8_BAR; PG8_SCHED;
            PG8_LDA(At, 0, 1); PG8_STAGE(PG8_SB(0, 0), b2, voffB); PG8_STAGE(PG8_SB(0, 1), b2 + hstepB, voffB); PG8_STAGE(PG8_SA(0, 0), a2, voffA);
            PG8_WAIT_V(8); PG8_WAIT_L(0); PG8_BAR; PG8_MMA(1, 0, At, B0); PG8_MMA(1, 1, At, B1); PG8_BAR; PG8_SCHED;
            PG8_LDB(B0, 1, 0); PG8_LDB(B1, 1, 1); PG8_SCHED; PG8_LDA(At, 1, 0); PG8_STAGE(PG8_SA(0, 1), a2 + hstepA, voffA);
            PG8_WAIT_V(8); PG8_WAIT_L(0); PG8_BAR; PG8_MMA(0, 0, At, B0); PG8_MMA(0, 1, At, B1); PG8_BAR; PG8_SCHED;
            PG8_LDA(At, 1, 1); PG8_STAGE(PG8_SB(1, 0), b3, voffB); PG8_STAGE(PG8_SB(1, 1), b3 + hstepB, voffB); PG8_STAGE(PG8_SA(1, 0), a3, voffA);
            PG8_WAIT_V(8); PG8_WAIT_L(0); PG8_BAR; PG8_MMA(1, 0, At, B0); PG8_MMA(1, 1, At, B1); PG8_BAR; PG8_SCHED;
        }
        if constexpr (ALIGN_EPI) { if (wr == 0) PG8_BAR; }
        if constexpr (!FUSED) E(acc, cur, wr, wc, fr, fq);
        if (!has_next) break;
#pragma unroll
        for (int a = 0; a < 2; ++a)
#pragma unroll
            for (int b = 0; b < 2; ++b)
#pragma unroll
                for (int m = 0; m < 4; ++m)
#pragma unroll
                    for (int n = 0; n < 2; ++n) acc[a][b][m][n] = (f32x4){0.f, 0.f, 0.f, 0.f};
        cur = nxt; cA = nA; cB = nB; ++ui;
        if constexpr (ALIGN_EPI) { if (wr == 1) PG8_BAR; }
    }
    PG8_WAIT_V(0);
    if constexpr (!ALIGN_EPI) { if (wr == 0) PG8_BAR; }
    PG8_BAR;
    return true;
#undef PG8_SA
#undef PG8_SB
#undef PG8_STAGE
#undef PG8_LDA
#undef PG8_LDB
#undef PG8_MMA
#undef PG8_WAIT_V
#undef PG8_WAIT_L
#undef PG8_BAR
#undef PG8_SCHED
}
}

__device__ __forceinline__ void transpose_item(const float* __restrict__ W, int N, bf16_t* WT, int ldt, int row_off, const float* __restrict__ gs, LAS float* scr, int item, int lane, bool late = false) {
    const int nblk = N / 64, kb = item / nblk, nb = item % nblk, k0 = 64 * kb, n0 = 64 * nb;
    const int ks = lane >> 4, n4 = lane & 15;
    f32x4 v[16];
#pragma unroll
    for (int i = 0; i < 16; ++i) v[i] = __builtin_nontemporal_load((const f32x4*)(W + (size_t)(k0 + 4 * i + ks) * N + n0 + 4 * n4));
    if (gs) {
#pragma unroll
        for (int i = 0; i < 16; ++i) v[i] = v[i] * gs[k0 + 4 * i + ks];
    }
#pragma unroll
    for (int i = 0; i < 16; ++i) { const int k = 4 * i + ks; scr[(4 * n4 + 0) * 65 + k] = v[i].x; scr[(4 * n4 + 1) * 65 + k] = v[i].y; scr[(4 * n4 + 2) * 65 + k] = v[i].z; scr[(4 * n4 + 3) * 65 + k] = v[i].w; }
    LDS_WAIT();
    const int c = lane & 7;
#pragma unroll
    for (int j = 0; j < 8; ++j) { const int n = (lane >> 3) + 8 * j; const LAS float* sp = scr + n * 65 + 8 * c;
        u32x4 o; o.x = pk2(sp[0], sp[1]); o.y = pk2(sp[2], sp[3]); o.z = pk2(sp[4], sp[5]); o.w = pk2(sp[6], sp[7]);
        if (late) __builtin_nontemporal_store(o, (u32x4*)(WT + (size_t)(row_off + n0 + n) * ldt + k0 + 8 * c)); else *(u32x4*)(WT + (size_t)(row_off + n0 + n) * ldt + k0 + 8 * c) = o; }
    LDS_WAIT();
}

typedef f32x2 cf;
__device__ __forceinline__ int PADI(int i) { return i + ((i >> 6) << 2); }
__device__ __forceinline__ cf cmul(cf a, cf b) { return (cf){a.x * b.x - a.y * b.y, a.x * b.y + a.y * b.x}; }
template <int SIGN> __device__ __forceinline__ void dft4(cf& a, cf& b, cf& c, cf& d) {
    const cf s0 = a + c, s1 = a - c, s2 = b + d, s3 = b - d;
    a = s0 + s2; c = s0 - s2;
    if (SIGN < 0) { b = (cf){s1.x + s3.y, s1.y - s3.x}; d = (cf){s1.x - s3.y, s1.y + s3.x}; }
    else          { b = (cf){s1.x - s3.y, s1.y + s3.x}; d = (cf){s1.x + s3.y, s1.y - s3.x}; }
}
template <int SIGN> __device__ __forceinline__ cf mulw(cf x, float c, float s) { return cmul(x, (cf){c, SIGN * s}); }
template <int SIGN> __device__ __forceinline__ void dft16(cf (&x)[16]) {
#pragma unroll
    for (int n2 = 0; n2 < 4; ++n2) dft4<SIGN>(x[n2], x[4 + n2], x[8 + n2], x[12 + n2]);
    constexpr float C1 = 0.92387953251f, S1 = 0.38268343236f, C2 = 0.70710678118f;
    x[5] = mulw<SIGN>(x[5], C1, S1); x[6] = mulw<SIGN>(x[6], C2, C2); x[7] = mulw<SIGN>(x[7], S1, C1);
    x[9] = mulw<SIGN>(x[9], C2, C2); x[10] = (SIGN < 0) ? (cf){x[10].y, -x[10].x} : (cf){-x[10].y, x[10].x}; x[11] = mulw<SIGN>(x[11], -C2, C2);
    x[13] = mulw<SIGN>(x[13], S1, C1); x[14] = mulw<SIGN>(x[14], -C2, C2); x[15] = mulw<SIGN>(x[15], -C1, -S1);
#pragma unroll
    for (int k1 = 0; k1 < 4; ++k1) dft4<SIGN>(x[4 * k1], x[4 * k1 + 1], x[4 * k1 + 2], x[4 * k1 + 3]);
}
template <int LOG2S, bool FWD> __device__ __forceinline__ void pass16(LAS cf* a, int tid) {
    constexpr int S = 1 << LOG2S, NC = 16 * S, PS = S + ((S >> 6) << 2);
#pragma unroll 1
    for (int r = 0; r < 2; ++r) {
        const int b = tid + 512 * r, j = b & (S - 1), blk = b >> LOG2S, base = blk * NC + j;
        LAS cf* ap = a + PADI(base);
        cf x[16];
#pragma unroll
        for (int k = 0; k < 16; ++k) x[k] = ap[k * PS];
        float jr = (float)j * (1.0f / NC);
        asm volatile("" : "+v"(jr));
        const cf w1 = {cos_rev(jr), FWD ? -sin_rev(jr) : sin_rev(jr)};
        cf w = w1;
        if (!FWD) {
#pragma unroll
            for (int k = 1; k < 16; ++k) { x[k] = cmul(x[k], w); if (k < 15) w = cmul(w, w1); }
            dft16<1>(x);
        } else {
            dft16<-1>(x);
#pragma unroll
            for (int k = 1; k < 16; ++k) { const int sl = 4 * (k & 3) + (k >> 2); x[sl] = cmul(x[sl], w); if (k < 15) w = cmul(w, w1); }
        }
#pragma unroll
        for (int k = 0; k < 16; ++k) ap[k * PS] = x[4 * (k & 3) + (k >> 2)];
    }
}
template <int SIGN> __device__ __forceinline__ void pass4(LAS cf* a, int tid) {
#pragma unroll 2
    for (int r = 0; r < 8; ++r) {
        const int p = PADI(4 * (tid + 512 * r));
        f32x4 u0 = *(LAS f32x4*)(a + p), u1 = *(LAS f32x4*)(a + p + 2);
        cf x0 = {u0.x, u0.y}, x1 = {u0.z, u0.w}, x2 = {u1.x, u1.y}, x3 = {u1.z, u1.w};
        dft4<SIGN>(x0, x1, x2, x3);
        *(LAS f32x4*)(a + p) = (f32x4){x0.x, x0.y, x1.x, x1.y}; *(LAS f32x4*)(a + p + 2) = (f32x4){x2.x, x2.y, x3.x, x3.y};
    }
}
__device__ __forceinline__ int fpos(int f) { return 1024 * (f & 15) + 64 * ((f >> 4) & 15) + 4 * ((f >> 8) & 15) + (f >> 12); }

struct RowBuf { f32x4 x[8], m[8]; float sp; };
__device__ __forceinline__ void row_load(RowBuf& b, const float* xin, const float* m, const float* sspart, int row, int lane) {
    const f32x4* xr = (const f32x4*)(xin + (size_t)row * D) + lane; const f32x4* mr = (const f32x4*)(m + (size_t)row * D) + lane;
    b.sp = (lane < 32) ? sspart[(size_t)row * 32 + lane] : 0.f;
#pragma unroll
    for (int j = 0; j < 8; ++j) { b.x[j] = xr[64 * j]; b.m[j] = mr[64 * j]; }
}
template <int MODE> __device__ __forceinline__ void row_compute(RowBuf& b, const f32x4 (&gv)[8], float* xout, bf16_t* bout, float* rnext, const float* __restrict__ gnext, int row, int lane) {
    const float rm = rsqrtf(wave_sum(b.sp) * (1.0f / D) + 1e-6f);
    float ss = 0.f;
    f32x4* xo = (f32x4*)(xout + (size_t)row * D) + lane;
#pragma unroll
    for (int j = 0; j < 8; ++j) { const f32x4 v = b.x[j] + b.m[j] * rm * gv[j]; b.x[j] = v; ss += (v.x * v.x + v.y * v.y) + (v.z * v.z + v.w * v.w); xo[64 * j] = v; }
    if (MODE != 2) {
        const float r = rsqrtf(wave_sum(ss) * (1.0f / D) + 1e-6f);
        u32x2* bo = (u32x2*)(bout + (size_t)row * D) + lane;
        if (MODE == 0) {
#pragma unroll
            for (int j = 0; j < 8; ++j) bo[64 * j] = (u32x2){pk2(b.x[j].x, b.x[j].y), pk2(b.x[j].z, b.x[j].w)};
            if (lane == 0) rnext[row] = r;
        } else {
            const f32x4* gn = (const f32x4*)gnext + lane;
#pragma unroll
            for (int j = 0; j < 8; ++j) { const f32x4 w = b.x[j] * r * gn[64 * j]; bo[64 * j] = (u32x2){pk2(w.x, w.y), pk2(w.z, w.w)}; }
        }
    }
}
template <int MODE> __device__ __forceinline__ void row_phase(const float* xin, const float* m, const float* sspart, const float* __restrict__ g, float* xout, bf16_t* bout, float* rnext, const float* __restrict__ gnext, int gw, int ngw, int lane) {
    if (gw >= L) return;
    f32x4 gv[8];
#pragma unroll
    for (int j = 0; j < 8; ++j) gv[j] = ((const f32x4*)g + lane)[64 * j];
    RowBuf A, B;
    row_load(A, xin, m, sspart, gw, lane);
    for (int row = gw; row < L; row += 2 * ngw) {
        const bool hasB = (row + ngw < L);
        if (hasB) row_load(B, xin, m, sspart, row + ngw, lane);
        row_compute<MODE>(A, gv, xout, bout, rnext, gnext, row, lane);
        if (row + 2 * ngw < L) row_load(A, xin, m, sspart, row + 2 * ngw, lane);
        if (hasB) row_compute<MODE>(B, gv, xout, bout, rnext, gnext, row + ngw, lane);
    }
}

#define XB_TMO      128
#define XB_XCNT(j)  (256  + 64 * (j))
#define XB_XSUB(j)  (1280 + 64 * (j))
#define XB_XGEN(j)  (2304 + 64 * (j))
#define XB_TOP      3328
#define XB_TOPGEN   3392
#define XCD_BAR_WORDS 3456
#define XB_SPIN_CAP (1u << 18)

__device__ __forceinline__ unsigned xb_ld(unsigned* p)              { return __hip_atomic_load(p, __ATOMIC_RELAXED, __HIP_MEMORY_SCOPE_AGENT); }
__device__ __forceinline__ unsigned xb_add(unsigned* p, unsigned v) { return __hip_atomic_fetch_add(p, v, __ATOMIC_RELAXED, __HIP_MEMORY_SCOPE_AGENT); }
__device__ __forceinline__ unsigned xb_xcc_id() { return (unsigned)__builtin_amdgcn_s_getreg((3 << 11) | 20) & 0xFu; }
#define XB_SPIN(cond, bar) do { unsigned _sp = 0; while (cond) { __builtin_amdgcn_s_sleep(1); \
    if ((++_sp & 255u) == 0u) { if (xb_ld(&(bar)[XB_TMO])) break; if (_sp > XB_SPIN_CAP) { atomicAdd(&(bar)[XB_TMO], 1u); break; } } } } while (0)

struct XcdBarrier {
    unsigned* bar; unsigned x;
    volatile LAS unsigned* st;
};

__device__ __forceinline__ XcdBarrier xcd_barrier_post(unsigned* bar, volatile LAS unsigned* st) {
    XcdBarrier b; b.bar = bar; b.x = xb_xcc_id(); b.st = st;
    if (threadIdx.x == 0) (void)xb_add(&bar[XB_XCNT(b.x)], 1u);
    return b;
}
__device__ __forceinline__ void xcd_barrier_complete(unsigned* bar, unsigned x, unsigned& nloc, unsigned& nx) {
    const unsigned G = gridDim.x * gridDim.y * gridDim.z;
    unsigned sum, cnt, mine, sp = 0u;
    for (;;) {
        sum = 0u; cnt = 0u; mine = 0u;
#pragma unroll
        for (unsigned j = 0; j < 16; ++j) { const unsigned c = xb_ld(&bar[XB_XCNT(j)]); sum += c; cnt += (c > 0u) ? 1u : 0u; mine = (j == x) ? c : mine; }
        if (sum == G) break;
        __builtin_amdgcn_s_sleep(1);
        if ((++sp & 255u) == 0u) { if (xb_ld(&bar[XB_TMO])) break; if (sp > XB_SPIN_CAP) { atomicAdd(&bar[XB_TMO], 1u); break; } }
    }
    nloc = mine > 0u ? mine : 1u; nx = cnt > 0u ? cnt : 1u;
}

__device__ __forceinline__ void xcd_barrier(const XcdBarrier& b) {
    asm volatile("s_waitcnt vmcnt(0)" ::: "memory");
    __syncthreads();
    if (threadIdx.x == 0) {
        unsigned* bar = b.bar;
        __builtin_amdgcn_s_waitcnt(0);
        unsigned nloc = b.st[0], nx = b.st[1];
        if (nloc == 0u) { xcd_barrier_complete(bar, b.x, nloc, nx); b.st[0] = nloc; b.st[1] = nx; }
        const unsigned old = xb_add(&bar[XB_XSUB(b.x)], 1u);
        const unsigned gen = old / nloc;
        if (old + 1u == (gen + 1u) * nloc) {
            __builtin_amdgcn_fence(__ATOMIC_RELEASE, "agent");
            asm volatile("s_waitcnt vmcnt(0)" ::: "memory");
            const unsigned og = xb_add(&bar[XB_TOP], 1u);
            const unsigned tg = og / nx;
            if (og + 1u == (tg + 1u) * nx) xb_add(&bar[XB_TOPGEN], 1u);
            else XB_SPIN(xb_ld(&bar[XB_TOPGEN]) == tg, bar);
            __builtin_amdgcn_fence(__ATOMIC_ACQUIRE, "agent");
            xb_add(&bar[XB_XGEN(b.x)], 1u);
            asm volatile("s_waitcnt vmcnt(0)" ::: "memory");
        } else {
            XB_SPIN(xb_ld(&bar[XB_XGEN(b.x)]) == gen, bar);
            __builtin_amdgcn_fence(__ATOMIC_ACQUIRE, "agent");
            asm volatile("s_waitcnt vmcnt(0)" ::: "memory");
        }
    }
    __syncthreads();
}


struct FusedArgs { const float* xin; float* xout; bf16_t* bout; float* rnext; const float* g; const float* gnext; const float* cs; float* ss1; float* ss2; };
__device__ __forceinline__ void panel_rms(const float* ss, int pm, LAS float* S, int tid) {
    const int r = tid >> 1, hf = tid & 1; const f32x4* p = (const f32x4*)(ss + (size_t)(pm * 256 + r) * 32 + hf * 16);
    const f32x4 a0 = p[0], a1 = p[1], a2 = p[2], a3 = p[3];
    float sm = ((a0.x + a0.y) + (a0.z + a0.w)) + ((a1.x + a1.y) + (a1.z + a1.w)) + ((a2.x + a2.y) + (a2.z + a2.w)) + ((a3.x + a3.y) + (a3.z + a3.w));
    sm += __shfl_xor(sm, 1);
    if (hf == 0) S[r] = rsqrtf(sm * (1.0f / D) + 1e-6f);
}
template <int MODE> __device__ __forceinline__ void fused_res_epilogue(f32x4 (&acc)[2][2][4][2], bool has, const pg8::Unit u, const FusedArgs& F, LAS float* S, const XcdBarrier& xbar, int tid) {
    const int lane = tid & 63, wid = __builtin_amdgcn_readfirstlane(tid >> 6), wr = wid >> 2, wc = wid & 3, fr = lane & 15, fq = lane >> 4;
    const int rowl0 = wr * 64 + fr, row0 = u.pm * 256 + rowl0, col0 = u.pn * 256 + wc * 32 + 8 * fq;
    if (has) {
        if (F.cs) {
#pragma unroll
            for (int bj = 0; bj < 2; ++bj)
#pragma unroll
                for (int n = 0; n < 2; ++n) { const f32x4 sv = *(const f32x4*)(F.cs + col0 + bj * 128 + n * 4);
#pragma unroll
                    for (int ai = 0; ai < 2; ++ai)
#pragma unroll
                        for (int m = 0; m < 4; ++m) acc[ai][bj][m][n] = acc[ai][bj][m][n] * sv; } }
#pragma unroll
        for (int ai = 0; ai < 2; ++ai)
#pragma unroll
            for (int m = 0; m < 4; ++m) { float sq = 0.f;
#pragma unroll
                for (int bj = 0; bj < 2; ++bj)
#pragma unroll
                    for (int n = 0; n < 2; ++n) { const f32x4 v = acc[ai][bj][m][n]; sq += (v[0] * v[0] + v[1] * v[1]) + (v[2] * v[2] + v[3] * v[3]); }
                sq += __shfl_xor(sq, 16); sq += __shfl_xor(sq, 32);
                if (fq == 0) F.ss1[(size_t)(row0 + ai * 128 + m * 16) * 32 + u.pn * 4 + wc] = sq; }
    }
    xcd_barrier(xbar);
    if (has) {
        panel_rms(F.ss1, u.pm, S, tid);
        __syncthreads();
        f32x4 gv[2][2];
#pragma unroll
        for (int bj = 0; bj < 2; ++bj)
#pragma unroll
            for (int n = 0; n < 2; ++n) gv[bj][n] = *(const f32x4*)(F.g + col0 + bj * 128 + n * 4);
#pragma unroll
        for (int ai = 0; ai < 2; ++ai) {
            f32x4 xv[4][2][2];
#pragma unroll
            for (int m = 0; m < 4; ++m) { const float* xr = F.xin + (size_t)(row0 + ai * 128 + m * 16) * D + col0;
#pragma unroll
                for (int bj = 0; bj < 2; ++bj)
#pragma unroll
                    for (int n = 0; n < 2; ++n) xv[m][bj][n] = *(const f32x4*)(xr + bj * 128 + n * 4); }
#pragma unroll
            for (int m = 0; m < 4; ++m) { const int rl = rowl0 + ai * 128 + m * 16, row = u.pm * 256 + rl; const float rm = S[rl]; float sq = 0.f;
                float* xo = F.xout + (size_t)row * D + col0;
#pragma unroll
                for (int bj = 0; bj < 2; ++bj)
#pragma unroll
                    for (int n = 0; n < 2; ++n) { const int co = bj * 128 + n * 4;
                        const f32x4 v = xv[m][bj][n] + acc[ai][bj][m][n] * rm * gv[bj][n]; acc[ai][bj][m][n] = v; *(f32x4*)(xo + co) = v;
                        sq += (v[0] * v[0] + v[1] * v[1]) + (v[2] * v[2] + v[3] * v[3]); }
                if (MODE != 2) { sq += __shfl_xor(sq, 16); sq += __shfl_xor(sq, 32);
                    if (fq == 0) F.ss2[(size_t)row * 32 + u.pn * 4 + wc] = sq; } }
        }
    }
    if (MODE == 2) return;
    xcd_barrier(xbar);
    if (has) {
        panel_rms(F.ss2, u.pm, S, tid);
        __syncthreads();
#pragma unroll
        for (int ai = 0; ai < 2; ++ai)
#pragma unroll
            for (int m = 0; m < 4; ++m) { const int rl = rowl0 + ai * 128 + m * 16, row = u.pm * 256 + rl; const float r = S[rl];
                bf16_t* bo = F.bout + (size_t)row * D + col0;
                if (MODE == 0 && u.pn == 0 && wc == 0 && fq == 0) F.rnext[row] = r;
#pragma unroll
                for (int bj = 0; bj < 2; ++bj)
                    { f32x4 v0 = acc[ai][bj][m][0], v1 = acc[ai][bj][m][1];
                        if (MODE == 1) { v0 = v0 * r * *(const f32x4*)(F.gnext + col0 + bj * 128); v1 = v1 * r * *(const f32x4*)(F.gnext + col0 + bj * 128 + 4); }
                        *(u32x4*)(bo + bj * 128) = (u32x4){pk2(v0[0], v0[1]), pk2(v0[2], v0[3]), pk2(v1[0], v1[1]), pk2(v1[2], v1[3])}; } }
    }
}

struct Args { const float* in[19]; float* out; unsigned char* ws; int ph_lo, ph_hi; };

__global__ void __launch_bounds__(512, 2) fwd_kernel(Args a) {
    extern __shared__ __attribute__((aligned(16))) unsigned char smem[];
    LAS unsigned char* lds = (LAS unsigned char*)smem;
    const int tid = threadIdx.x, lane = tid & 63, wave = __builtin_amdgcn_readfirstlane(tid >> 6);
    const int G = gridDim.x, bid = blockIdx.x, gw = bid * 8 + wave, NGW = G * 8;
    unsigned char* ws = a.ws;
    const float* x = a.in[0]; const float* norm_g = a.in[1];
    bf16_t* Wt_in = (bf16_t*)(ws + WS_WIN); bf16_t* Wt_out = (bf16_t*)(ws + WS_WOUT); bf16_t* Wt_1 = (bf16_t*)(ws + WS_W1); bf16_t* Wt_2 = (bf16_t*)(ws + WS_W2); bf16_t* Wt_pool = (bf16_t*)(ws + WS_WPOOL);
    float* rA = (float*)(ws + WS_SMALL); float* hid2 = (float*)(ws + WS_SMALL + 1 * MiB); float* sspart = (float*)(ws + WS_SMALL + 3 * MiB); float* sspart2 = (float*)(ws + WS_SMALL + 128 * 1024);
    bf16_t* abuf = (bf16_t*)(ws + WS_ABUF);
    bf16_t* x0T = (bf16_t*)(ws + WS_ABUF2); bf16_t* yaT = (bf16_t*)(ws + WS_ABUF2 + 16 * MiB); bf16_t* hb = (bf16_t*)(ws + WS_ABUF2);
    float* KT = (float*)(ws + WS_M); float* mbuf = (float*)(ws + WS_M);
    bf16_t* Z = (bf16_t*)(ws + WS_H); float* uT = (float*)(ws + WS_H + 96 * MiB); bf16_t* hmid = (bf16_t*)(ws + WS_H);
    float* xres = a.out;
    cg::grid_group grid = cg::this_grid();
    const int lo = a.ph_lo, hi = a.ph_hi;
#ifndef PHMASK
#define PHMASK 0xFFFF
#endif
#define IN(k) (((PHMASK >> (k)) & 1) && lo <= (k) && (k) < hi)
#define SEAM(k) do { if (IN(k) && IN((k) + 1)) { if (a.ph_hi > NPHASE) grid.sync(); xcd_barrier(xbar); } } while (0)
    {   volatile LAS unsigned* st = (volatile LAS unsigned*)(lds + FFT_LDS_BYTES);
        if (tid < 16) st[tid] = 0u;
        __syncthreads(); }
    const XcdBarrier xbar = xcd_barrier_post((unsigned*)(ws + WS_CTL), (volatile LAS unsigned*)(lds + FFT_LDS_BYTES));

    if (IN(0)) {
        LAS float* scr = (LAS float*)(lds + wave * 16640);
        constexpr int I_IN = 32 * 96, I_OUT = 32 * 32, I_1 = 32 * 128, I_2 = 128 * 32, I_P = 8 * 8;
        constexpr int NITEMS = I_IN + I_OUT + 2 * I_1 + 2 * I_2 + 4 * I_P;
        for (int it = gw; it < NITEMS; it += NGW) {
            int r = it;
            if (r < I_IN) { transpose_item(a.in[2], DIN, Wt_in, D, 0, norm_g + 0 * D, scr, r, lane); continue; } r -= I_IN;
            if (r < I_OUT) { transpose_item(a.in[14], D, Wt_out, D, 0, nullptr, scr, r, lane); continue; } r -= I_OUT;
            if (r < 2 * I_1) { const int l = r / I_1; transpose_item(a.in[17] + (size_t)l * D * DFF, DFF, Wt_1 + (size_t)l * DFF * D, D, 0, norm_g + (l * 4 + 2) * D, scr, r % I_1, lane, l == 1); continue; } r -= 2 * I_1;
            if (r < 2 * I_2) { const int l = r / I_2; transpose_item(a.in[18] + (size_t)l * DFF * D, D, Wt_2 + (size_t)l * D * DFF, DFF, 0, nullptr, scr, r % I_2, lane, l == 1); continue; } r -= 2 * I_2;
            { const int gq = r / I_P; transpose_item(a.in[15] + (size_t)gq * 512 * 512, 512, Wt_pool, 512, gq * 512, nullptr, scr, r % I_P, lane); }
        }
        for (int row = gw; row < L; row += NGW) {
            const f32x4* xr = (const f32x4*)(x + (size_t)row * D) + lane; u32x2* bo = (u32x2*)(abuf + (size_t)row * D) + lane; float ss = 0.f;
#pragma unroll
            for (int j = 0; j < 8; ++j) { const f32x4 v = __builtin_nontemporal_load(xr + 64 * j); ss += (v.x * v.x + v.y * v.y) + (v.z * v.z + v.w * v.w); bo[64 * j] = (u32x2){pk2(v.x, v.y), pk2(v.z, v.w)}; }
            const float r = rsqrtf(wave_sum(ss) * (1.0f / D) + 1e-6f);
            if (lane == 0) rA[row] = r;
        }
        {
            const float* w1 = a.in[5]; const float* b1 = a.in[6]; const float* w2 = a.in[7]; const float* b2 = a.in[8]; const float fr = a.in[11][lane];
            for (int t = gw; t < L; t += NGW) {
                const int e = lane; float val;
                {   const int b = (e >= 17) ? (e - 17) : (e - 1);
                    const float band = 1e-4f + (float)b * ((15.0f - 1e-4f) / 15.0f);
                    float rev = ((float)t * (1.0f / 8192.0f)) * band; rev -= floorf(rev);
                    val = (e == 0) ? (float)t * (1.0f / 8191.0f) : ((e <= 16) ? cos_rev(rev) : -sin_rev(rev)); }
                float z1 = b1[lane];
#pragma unroll
                for (int i = 0; i < 33; ++i) z1 += __int_as_float(__builtin_amdgcn_readlane(__float_as_int(val), i)) * w1[i * 64 + lane];
                const float h1 = sin_rev(fr * z1 * 0.15915494309189535f);
                float z2 = b2[lane];
#pragma unroll
                for (int i = 0; i < 64; ++i) z2 += __int_as_float(__builtin_amdgcn_readlane(__float_as_int(h1), i)) * w2[i * 64 + lane];
                hid2[(size_t)t * 64 + lane] = sin_rev(fr * z2 * 0.15915494309189535f);
            }
        }
    }
    SEAM(0);

    if (IN(1)) {
        { pg8::Gemm g{abuf, Wt_in, L, DIN, D, D, D, 0}; pg8::StaticOrder S; S.init(L, DIN, G, bid);
          pg8::EpiRowScaleBf16<false> E{Z, DIN, rA};
          f32x4 acc[2][2][4][2]; pg8::Unit cu; pg8::gemm_phase<pg8::EpiRowScaleBf16<false>, true>(lds, g, S, E, acc, cu); }
        {
            typedef float f32x16 __attribute__((ext_vector_type(16)));
            const float* w3 = a.in[9]; const float* b3 = a.in[10];
            const int cl = lane & 31, h = lane >> 5;
            auto split8 = [](const float (&v)[8], bf16x8& hi, bf16x8& lo) {
                u32x4 hw, lw; unsigned hh[4], ll[4];
#pragma unroll
                for (int i = 0; i < 4; ++i) { hh[i] = pk2(v[2 * i], v[2 * i + 1]); ll[i] = pk2(v[2 * i] - bf_lo(hh[i]), v[2 * i + 1] - bf_hi(hh[i])); }
                hw = (u32x4){hh[0], hh[1], hh[2], hh[3]}; lw = (u32x4){ll[0], ll[1], ll[2], ll[3]};
                hi = __builtin_bit_cast(bf16x8, hw); lo = __builtin_bit_cast(bf16x8, lw); };
            for (int it = gw; it < 64 * 64; it += NGW) {
                const int cb = it >> 6, tq = it & 63, c0 = cb * 32;
                bf16x8 ahi[4], alo[4];
#pragma unroll
                for (int sidx = 0; sidx < 4; ++sidx) { float av[8];
#pragma unroll
                    for (int e = 0; e < 8; ++e) av[e] = w3[(size_t)(16 * sidx + 8 * h + e) * 2048 + c0 + cl];
                    split8(av, ahi[sidx], alo[sidx]); }
                constexpr float DMIN = -3.0701134573253943f, DMAX = -15.350567286626972f;
#pragma unroll 1
                for (int q = 0; q < 4; ++q) {
                    const int tg = tq * 128 + q * 32 + cl;
                    f32x4 bv[8];
#pragma unroll
                    for (int i = 0; i < 8; ++i) bv[i] = *(const f32x4*)(hid2 + (size_t)tg * 64 + 16 * (i >> 1) + 8 * h + 4 * (i & 1));
                    f32x16 acc = {0.f, 0.f, 0.f, 0.f, 0.f, 0.f, 0.f, 0.f, 0.f, 0.f, 0.f, 0.f, 0.f, 0.f, 0.f, 0.f};
#pragma unroll
                    for (int sidx = 0; sidx < 4; ++sidx) { const float bvv[8] = {bv[2 * sidx].x, bv[2 * sidx].y, bv[2 * sidx].z, bv[2 * sidx].w, bv[2 * sidx + 1].x, bv[2 * sidx + 1].y, bv[2 * sidx + 1].z, bv[2 * sidx + 1].w};
                        bf16x8 bhi, blo; split8(bvv, bhi, blo);
                        acc = __builtin_amdgcn_mfma_f32_32x32x16_bf16(alo[sidx], bhi, acc, 0, 0, 0);
                        acc = __builtin_amdgcn_mfma_f32_32x32x16_bf16(ahi[sidx], blo, acc, 0, 0, 0);
                        acc = __builtin_amdgcn_mfma_f32_32x32x16_bf16(ahi[sidx], bhi, acc, 0, 0, 0); }
                    const float tl = (float)tg * (1.0f / 8191.0f);
                    int zoff = 0; asm volatile("" : "+v"(zoff));
#pragma unroll
                    for (int i = 0; i < 16; ++i) { const int c = c0 + 8 * (i >> 2) + 4 * h + (i & 3) + zoff, ch = c & 1023;
                        const float dlt = fabsf(DMIN + (float)ch * ((DMAX - DMIN) / 1023.0f));
                        const float val = (acc[i] + b3[c]) * __expf(-tl * dlt);
                        if (c < 1024) KT[(size_t)ch * NFFT + tg] = val;
                        else { if (tg >= 1) KT[(size_t)ch * NFFT + (NFFT - tg)] = val; else KT[(size_t)ch * NFFT + 8192] = 0.f; } }
                }
            }
        }
    }
    SEAM(1);

    if (IN(2)) {
        const float* hw = a.in[3]; const float* hbias = a.in[4]; const float* scw = a.in[13];
        bf16_t* ycat = abuf;
        LAS float* wl = (LAS float*)lds;
        LAS float* sbuf = (LAS float*)(lds + 4096);
        const int tt = tid >> 3, cg8 = tid & 7;
        const u32x4 zero4 = {0u, 0u, 0u, 0u};
        {
            u32x4 zr[3][3]; int cur_cb = -1, par = 0;
            auto issue = [&](int it) { const int tb = it >> 4, cb = it & 15, t = tb * 64 + tt, c8 = cb * 64 + cg8 * 8;
#pragma unroll
                for (int s3 = 0; s3 < 3; ++s3)
#pragma unroll
                    for (int d = 0; d < 3; ++d) { const int tr = t + d - 1; zr[s3][d] = (tr >= 0 && tr < L) ? *(const u32x4*)(Z + (size_t)tr * DIN + s3 * 1024 + c8) : zero4; } };
            if (bid < 2048) issue(bid);
            for (int it = bid; it < 2048; it += G, par ^= 1) {
                const int tb = it >> 4, cb = it & 15;
                if (cb != cur_cb) {
                    __syncthreads();
                    for (int i = tid; i < 768; i += 512) { const int rw = i >> 6, ch = i & 63, s3 = rw >> 2, k = rw & 3; wl[i] = (k < 3) ? hw[k * 3072 + s3 * 1024 + cb * 64 + ch] : hbias[s3 * 1024 + cb * 64 + ch]; }
                    __syncthreads(); cur_cb = cb; }
                float hy[3][8];
#pragma unroll
                for (int s3 = 0; s3 < 3; ++s3) { float zm[8], z0[8], zp[8]; unpack8(zr[s3][0], zm); unpack8(zr[s3][1], z0); unpack8(zr[s3][2], zp);
                    float w0[8], w1[8], w2[8], bb[8];
#pragma unroll
                    for (int hq = 0; hq < 2; ++hq) { const f32x4 a0 = *(LAS f32x4*)(wl + (4 * s3 + 0) * 64 + cg8 * 8 + 4 * hq), a1 = *(LAS f32x4*)(wl + (4 * s3 + 1) * 64 + cg8 * 8 + 4 * hq), a2 = *(LAS f32x4*)(wl + (4 * s3 + 2) * 64 + cg8 * 8 + 4 * hq), a3 = *(LAS f32x4*)(wl + (4 * s3 + 3) * 64 + cg8 * 8 + 4 * hq);
#pragma unroll
                        for (int j = 0; j < 4; ++j) { w0[4 * hq + j] = a0[j]; w1[4 * hq + j] = a1[j]; w2[4 * hq + j] = a2[j]; bb[4 * hq + j] = a3[j]; } }
#pragma unroll
                    for (int i = 0; i < 8; ++i) hy[s3][i] = w0[i] * zm[i] + w1[i] * z0[i] + w2[i] * zp[i] + bb[i]; }
                if (it + G < 2048) issue(it + G);
                LAS float* su = sbuf + par * (2 * 64 * 65); LAS float* sx = su + 64 * 65;
#pragma unroll
                for (int i = 0; i < 8; ++i) { su[(cg8 * 8 + i) * 65 + tt] = hy[2][i] * hy[1][i]; sx[(cg8 * 8 + i) * 65 + tt] = hy[0][i]; }
                __syncthreads();
                const int c = tid >> 3, ch = tid & 7;
                float uo[8], xo[8];
#pragma unroll
                for (int i = 0; i < 8; ++i) { uo[i] = su[c * 65 + ch * 8 + i]; xo[i] = sx[c * 65 + ch * 8 + i]; }
                float* up = uT + (size_t)(cb * 64 + c) * L + tb * 64 + ch * 8;
                *(f32x4*)up = (f32x4){uo[0], uo[1], uo[2], uo[3]}; *(f32x4*)(up + 4) = (f32x4){uo[4], uo[5], uo[6], uo[7]};
                *(u32x4*)(x0T + (size_t)(cb * 64 + c) * L + tb * 64 + ch * 8) = pack8(xo);
            }
        }
        {
            u32x4 rg, rc[3], rx[3];
            auto issue = [&](int it) { const int tb = it >> 4, cb = it & 15, t = tb * 64 + tt, c8 = cb * 64 + cg8 * 8;
                rg = *(const u32x4*)(Z + (size_t)t * DIN + 3072 + c8);
#pragma unroll
                for (int d = 0; d < 3; ++d) { const int tr = t + d - 1; const bool ok = (tr >= 0 && tr < L);
                    rc[d] = ok ? *(const u32x4*)(Z + (size_t)tr * DIN + 4096 + c8) : zero4; rx[d] = ok ? *(const u32x4*)(Z + (size_t)tr * DIN + 5120 + c8) : zero4; } };
            if (bid < 2048) issue(bid);
            for (int it = bid; it < 2048; it += G) {
                const int tb = it >> 4, cb = it & 15, t = tb * 64 + tt, c8 = cb * 64 + cg8 * 8;
                float gb[8], p[3][8];
                unpack8(rg, gb);
#pragma unroll
                for (int d = 0; d < 3; ++d) { float gc[8], xv[8]; unpack8(rc[d], gc); unpack8(rx[d], xv);
#pragma unroll
                    for (int i = 0; i < 8; ++i) p[d][i] = gc[i] * xv[i]; }
                if (it + G < 2048) issue(it + G);
                float yb[8];
#pragma unroll
                for (int i = 0; i < 8; ++i) yb[i] = gb[i] * (scw[c8 + i] * p[0][i] + scw[1024 + c8 + i] * p[1][i] + scw[2048 + c8 + i] * p[2][i]);
                *(u32x4*)(ycat + (size_t)t * D + 1024 + c8) = pack8(yb);
            }
        }
    }
    SEAM(2);

    if (IN(3)) {
        LAS cf* fa = (LAS cf*)lds; const float* hyb = a.in[12];
        f32x4 pkv[8], puv[4];
        if (bid < DHY) { const float* up0 = uT + (size_t)bid * L; const float* kp0 = KT + (size_t)bid * NFFT;
#pragma unroll
            for (int r = 0; r < 8; ++r) pkv[r] = __builtin_nontemporal_load((const f32x4*)(kp0 + 4 * (tid + 512 * r)));
#pragma unroll
            for (int r = 0; r < 4; ++r) puv[r] = *(const f32x4*)(up0 + 4 * (tid + 512 * r)); }
        cf Yr[16]; float Yh = 0.f; int kidx = 0;
        for (int c = bid; c < DHY; c += G, ++kidx) {
            const bool second = (kidx & 1) != 0, hold = (!second && (c + G < DHY));
            __syncthreads();
#pragma unroll
            for (int r = 0; r < 8; ++r) { const int n = 4 * (tid + 512 * r);
                const f32x4 kv = pkv[r]; const f32x4 uv = (r < 4) ? puv[r & 3] : (f32x4){0.f, 0.f, 0.f, 0.f};
                const int p = PADI(n);
                *(LAS f32x4*)(fa + p) = (f32x4){uv.x, kv.x, uv.y, kv.y}; *(LAS f32x4*)(fa + p + 2) = (f32x4){uv.z, kv.z, uv.w, kv.w}; }
            if (c + G < DHY) { const float* up1 = uT + (size_t)(c + G) * L; const float* kp1 = KT + (size_t)(c + G) * NFFT;
#pragma unroll
                for (int r = 0; r < 8; ++r) pkv[r] = __builtin_nontemporal_load((const f32x4*)(kp1 + 4 * (tid + 512 * r)));
#pragma unroll
                for (int r = 0; r < 4; ++r) puv[r] = *(const f32x4*)(up1 + 4 * (tid + 512 * r)); }
            __syncthreads();
            pass16<10, true>(fa, tid); __syncthreads();
            pass16<6, true>(fa, tid); __syncthreads();
            pass16<2, true>(fa, tid); __syncthreads();
            pass4<-1>(fa, tid); __syncthreads();
            {   const float sc = 0.25f / (float)NFFT;
#pragma unroll
                for (int r = 0; r < 16; ++r) { const int idx = tid + 512 * r;
                    const int f = (idx >> 9) + 16 * ((idx >> 5) & 15) + 256 * ((idx >> 1) & 15) + 4096 * (idx & 1);
                    const int fp = (NFFT - f) & (NFFT - 1);
                    const int p = PADI(fpos(f)), pp = PADI(fpos(fp));
                    const cf A = fa[p], Bc = fa[pp];
                    const float dx = (A.x * A.x - A.y * A.y) - (Bc.x * Bc.x - Bc.y * Bc.y), dy = 2.f * A.x * A.y + 2.f * Bc.x * Bc.y;
                    const cf Y = {dy * sc, -dx * sc};
                    if (hold) Yr[r] = Y;
                    else if (second) { const cf Y1 = Yr[r]; fa[p] = (cf){Y1.x - Y.y, Y1.y + Y.x}; fa[pp] = (cf){Y1.x + Y.y, Y.x - Y1.y}; }
                    else { fa[p] = Y; fa[pp] = (cf){Y.x, -Y.y}; } }
                if (tid == 0) { const int p = PADI(2); const cf A = fa[p]; const float yh = A.x * A.y * (1.0f / (float)NFFT);
                    if (hold) Yh = yh; else if (second) fa[p] = (cf){Yh, yh}; else fa[p] = (cf){yh, 0.f}; }
            }
            if (hold) continue;
            __syncthreads();
            pass4<1>(fa, tid); __syncthreads();
            pass16<2, false>(fa, tid); __syncthreads();
            pass16<6, false>(fa, tid); __syncthreads();
            const int c1 = second ? c - G : c;
            f32x4 ou0[2][2], ou1[2][2]; u32x4 ox0[2][2];
#pragma unroll
            for (int q = 0; q < 2; ++q) { const int cc = q ? c : c1;
#pragma unroll
                for (int r = 0; r < 2; ++r) { const int t0 = 8 * (tid + 512 * r); const float* upq = uT + (size_t)cc * L;
                    ou0[q][r] = *(const f32x4*)(upq + t0); ou1[q][r] = *(const f32x4*)(upq + t0 + 4); ox0[q][r] = *(const u32x4*)(x0T + (size_t)cc * L + t0); } }
            pass16<10, false>(fa, tid); __syncthreads();
#pragma unroll
            for (int q = 0; q < 2; ++q) { if (q == 1 && !second) break;
                const int cc = q ? c : c1; const float bias = hyb[cc];
#pragma unroll
                for (int r = 0; r < 2; ++r) { const int t0 = 8 * (tid + 512 * r); const int p = PADI(t0);
                    float y[8];
#pragma unroll
                    for (int i = 0; i < 4; ++i) { const f32x4 qv = *(LAS f32x4*)(fa + p + 2 * i); y[2 * i] = q ? qv.y : qv.x; y[2 * i + 1] = q ? qv.w : qv.z; }
                    float x0v[8]; unpack8(ox0[q][r], x0v);
                    const float uu[8] = {ou0[q][r].x, ou0[q][r].y, ou0[q][r].z, ou0[q][r].w, ou1[q][r].x, ou1[q][r].y, ou1[q][r].z, ou1[q][r].w};
                    float o[8];
#pragma unroll
                    for (int i = 0; i < 8; ++i) o[i] = x0v[i] * (y[i] + bias * uu[i]);
                    *(u32x4*)(yaT + (size_t)cc * L + t0) = pack8(o); } }
        }
    }
    SEAM(3);

    if (IN(4)) {
        bf16_t* ycat = abuf;
        for (int item = bid; item < 128 * 8; item += G) {
            const int tb = item >> 3, cb = item & 7, t0 = tb * 64 + wave * 8, c2 = cb * 128 + 2 * lane;
            const u32x4 ra = *(const u32x4*)(yaT + (size_t)c2 * L + t0), rb = *(const u32x4*)(yaT + (size_t)(c2 + 1) * L + t0);
            const unsigned wa[4] = {ra.x, ra.y, ra.z, ra.w}, wb[4] = {rb.x, rb.y, rb.z, rb.w};
#pragma unroll
            for (int i = 0; i < 4; ++i) {
                *(unsigned*)(ycat + (size_t)(t0 + 2 * i) * D + c2) = (wa[i] & 0xffffu) | (wb[i] << 16);
                *(unsigned*)(ycat + (size_t)(t0 + 2 * i + 1) * D + c2) = (wa[i] >> 16) | (wb[i] & 0xffff0000u); }
        }
    }
    SEAM(4);

    if (IN(5)) {
        pg8::Gemm g{abuf, Wt_out, L, D, D, D, D, 0}; pg8::StaticOrder S; S.init(L, D, G, bid);
        pg8::EpiRowScaleBf16<false> E{nullptr, D, nullptr};
        f32x4 acc[2][2][4][2]; pg8::Unit cu{0, 0}; const bool has = pg8::gemm_phase<pg8::EpiRowScaleBf16<false>, false, true>(lds, g, S, E, acc, cu);
        const FusedArgs F{x, xres, abuf, rA, norm_g + 1 * D, nullptr, nullptr, sspart, sspart2};
        fused_res_epilogue<0>(acc, has, cu, F, (LAS float*)lds, xbar, tid);
    }
    SEAM(5);
    if (IN(7)) {
        pg8::Gemm g{abuf, Wt_1, L, DFF, D, D, D, 0}; pg8::StaticOrder S; S.init(L, DFF, G, bid);
        pg8::EpiRowScaleBf16<true> E{hmid, DFF, rA};
        f32x4 acc[2][2][4][2]; pg8::Unit cu; pg8::gemm_phase<pg8::EpiRowScaleBf16<true>, true>(lds, g, S, E, acc, cu);
    }
    SEAM(7);
    if (IN(8)) {
        pg8::Gemm g{hmid, Wt_2, L, D, DFF, DFF, DFF, 0}; pg8::StaticOrder S; S.init(L, D, G, bid);
        pg8::EpiRowScaleBf16<false> E{nullptr, D, nullptr};
        f32x4 acc[2][2][4][2]; pg8::Unit cu{0, 0}; const bool has = pg8::gemm_phase<pg8::EpiRowScaleBf16<false>, false, true>(lds, g, S, E, acc, cu);
        const FusedArgs F{xres, xres, hb, nullptr, norm_g + 3 * D, norm_g + 4 * D, nullptr, sspart, sspart2};
        fused_res_epilogue<1>(acc, has, cu, F, (LAS float*)lds, xbar, tid);
    }
    SEAM(8);
    if (IN(10)) {
        const int chunk = tid & 255, c8 = chunk * 8, rsel = (tid >> 6) & 3;
        for (int it = bid * 2 + (tid >> 8); it < 1024; it += 2 * G) {
            const int t0 = it * 8;
            auto body = [&](auto RC) {
                constexpr int R = decltype(RC)::value;
                u32x4 rows[8 + 2 * R]; const u32x4 zero = {0u, 0u, 0u, 0u};
#pragma unroll
                for (int i = 0; i < 8 + 2 * R; ++i) { const int tr = t0 - R + i; rows[i] = (tr >= 0 && tr < L) ? *(const u32x4*)(hb + (size_t)tr * D + c8) : zero; }
                float S[8];
#pragma unroll
                for (int i = 0; i < 8; ++i) S[i] = 0.f;
#pragma unroll
                for (int j = 0; j < 2 * R + 1; ++j) { float v[8]; unpack8(rows[j], v);
#pragma unroll
                    for (int i = 0; i < 8; ++i) S[i] += v[i]; }
#pragma unroll
                for (int k = 0; k < 8; ++k) {
                    const int t = t0 + k, lo2 = max(t - R, 0), hi2 = min(t + R + 1, L); const float inv = 1.0f / (float)(hi2 - lo2);
                    float hv[8], o[8]; unpack8(rows[k + R], hv);
#pragma unroll
                    for (int i = 0; i < 8; ++i) o[i] = S[i] * inv - hv[i];
                    *(u32x4*)(abuf + (size_t)t * D + c8) = pack8(o);
                    if (k < 7) { float va[8], vs[8]; unpack8(rows[k + 2 * R + 1], va); unpack8(rows[k], vs);
#pragma unroll
                        for (int i = 0; i < 8; ++i) S[i] += va[i] - vs[i]; }
                }
            };
            if (rsel == 0) body(std::integral_constant<int, 1>{}); else if (rsel == 1) body(std::integral_constant<int, 2>{});
            else if (rsel == 2) body(std::integral_constant<int, 4>{}); else body(std::integral_constant<int, 8>{});
        }
    }
    SEAM(10);
    if (IN(11)) {
        pg8::Gemm g{abuf, Wt_pool, L, D, 512, D, 512, 512}; pg8::StaticOrder S; S.init(L, D, G, bid);
        pg8::EpiRowScaleBf16<false> E{nullptr, D, nullptr};
        f32x4 acc[2][2][4][2]; pg8::Unit cu{0, 0}; const bool has = pg8::gemm_phase<pg8::EpiRowScaleBf16<false>, false, true>(lds, g, S, E, acc, cu);
        const FusedArgs F{xres, xres, abuf, rA, norm_g + 5 * D, nullptr, a.in[16], sspart, sspart2};
        fused_res_epilogue<0>(acc, has, cu, F, (LAS float*)lds, xbar, tid);
    }
    SEAM(11);
    if (IN(13)) {
        pg8::Gemm g{abuf, Wt_1 + (size_t)DFF * D, L, DFF, D, D, D, 0}; pg8::StaticOrder S; S.init(L, DFF, G, bid);
        pg8::EpiRowScaleBf16<true> E{hmid, DFF, rA};
        f32x4 acc[2][2][4][2]; pg8::Unit cu; pg8::gemm_phase<pg8::EpiRowScaleBf16<true>, true>(lds, g, S, E, acc, cu);
    }
    SEAM(13);
    if (IN(14)) {
        pg8::Gemm g{hmid, Wt_2 + (size_t)D * DFF, L, D, DFF, DFF, DFF, 0}; pg8::StaticOrder S; S.init(L, D, G, bid);
        pg8::EpiRowScaleBf16<false> E{nullptr, D, nullptr};
        f32x4 acc[2][2][4][2]; pg8::Unit cu{0, 0}; const bool has = pg8::gemm_phase<pg8::EpiRowScaleBf16<false>, false, true>(lds, g, S, E, acc, cu);
        const FusedArgs F{xres, xres, nullptr, nullptr, norm_g + 7 * D, nullptr, nullptr, sspart, sspart2};
        fused_res_epilogue<2>(acc, has, cu, F, (LAS float*)lds, xbar, tid);
    }
}


extern "C" void kernel_launch(void* const* d_in, const int* in_sizes, int n_in, void* d_out, int out_size, void* d_ws, size_t ws_size, hipStream_t stream) {
    static int grid = 0;
    if (grid == 0) {
        if (n_in != 19 || out_size != L * D || ws_size < WS_END) { fprintf(stderr, "kernel_launch: unexpected shapes (n_in %d out %d ws %zu)\n", n_in, out_size, ws_size); grid = -1; return; }
        int dev = 0, cus = 0, per_cu = 0;
        hipGetDevice(&dev); hipDeviceGetAttribute(&cus, hipDeviceAttributeMultiprocessorCount, dev);
        if (hipFuncSetAttribute((const void*)fwd_kernel, hipFuncAttributeMaxDynamicSharedMemorySize, LDS_BYTES) != hipSuccess) { fprintf(stderr, "kernel_launch: hipFuncSetAttribute failed\n"); grid = -1; return; }
        if (hipOccupancyMaxActiveBlocksPerMultiprocessor(&per_cu, (const void*)fwd_kernel, 512, LDS_BYTES) != hipSuccess || per_cu < 1) { fprintf(stderr, "kernel_launch: occupancy query says %d\n", per_cu); per_cu = 1; }
        (void)hipGetLastError();
        grid = cus * per_cu;
        if (grid < 256) { fprintf(stderr, "kernel_launch: the fused GEMM epilogues need >= 256 co-resident workgroups, got %d\n", grid); grid = -1; return; }
    }
    if (grid < 0) return;
    if (hipMemsetAsync((char*)d_ws + WS_CTL, 0, CTL_BYTES, stream) != hipSuccess) { fprintf(stderr, "kernel_launch: memset failed\n"); return; }
    Args a{};
    for (int i = 0; i < 19; ++i) a.in[i] = (const float*)d_in[i];
    a.out = (float*)d_out; a.ws = (unsigned char*)d_ws;
    a.ph_lo = 0; a.ph_hi = NPHASE;
    void* args[] = {&a};
    hipError_t e = hipLaunchCooperativeKernel((const void*)fwd_kernel, dim3(grid), dim3(512), args, LDS_BYTES, stream);
    if (e != hipSuccess) fprintf(stderr, "cooperative launch failed: %s (grid %d)\n", hipGetErrorString(e), grid);
}
```

```cpp
#include <hip/hip_runtime.h>
#include <hip/hip_cooperative_groups.h>
#include <cstdio>
#include <cstdint>
#include <type_traits>
namespace cg = cooperative_groups;


#define LAS __attribute__((address_space(3)))
typedef unsigned short bf16_t;
typedef short bf16x8 __attribute__((ext_vector_type(8)));
typedef float f32x4 __attribute__((ext_vector_type(4)));
typedef float f32x2 __attribute__((ext_vector_type(2)));
typedef unsigned u32x4 __attribute__((ext_vector_type(4)));
typedef unsigned u32x2 __attribute__((ext_vector_type(2)));

constexpr int L = 8192, D = 2048, DIN = 6144, DHY = 1024, DFF = 8192, NFFT = 16384;
constexpr size_t MiB = 1024ull * 1024ull;
constexpr size_t WS_WIN = 0, WS_WOUT = 24 * MiB, WS_W1 = 32 * MiB, WS_W2 = 96 * MiB, WS_WPOOL = 160 * MiB, WS_SMALL = 162 * MiB,
                 WS_ABUF = 166 * MiB, WS_ABUF2 = 198 * MiB, WS_M = 230 * MiB, WS_H = 294 * MiB, WS_END = 422 * MiB;
constexpr int FFT_LDS_BYTES = (NFFT / 64) * 68 * 8;
constexpr int LDS_BYTES = FFT_LDS_BYTES + 64;
constexpr size_t WS_CTL = WS_SMALL + 64 * 1024, CTL_BYTES = 16 * 1024;
constexpr int NPHASE = 16;

__device__ __forceinline__ unsigned pk2(float lo, float hi) { unsigned r; asm volatile("v_cvt_pk_bf16_f32 %0, %1, %2" : "=v"(r) : "v"(lo), "v"(hi)); return r; }
__device__ __forceinline__ float bf_lo(unsigned w) { return __uint_as_float(w << 16); }
__device__ __forceinline__ float bf_hi(unsigned w) { return __uint_as_float(w & 0xffff0000u); }
__device__ __forceinline__ void unpack8(u32x4 w, float* f) { f[0] = bf_lo(w.x); f[1] = bf_hi(w.x); f[2] = bf_lo(w.y); f[3] = bf_hi(w.y); f[4] = bf_lo(w.z); f[5] = bf_hi(w.z); f[6] = bf_lo(w.w); f[7] = bf_hi(w.w); }
__device__ __forceinline__ u32x4 pack8(const float* f) { u32x4 o; o.x = pk2(f[0], f[1]); o.y = pk2(f[2], f[3]); o.z = pk2(f[4], f[5]); o.w = pk2(f[6], f[7]); return o; }
__device__ __forceinline__ float wave_sum(float v) {
#pragma unroll
    for (int o = 1; o < 64; o <<= 1) v += __shfl_xor(v, o);
    return v;
}
__device__ __forceinline__ float sin_rev(float r) { return __builtin_amdgcn_sinf(r); }
__device__ __forceinline__ float cos_rev(float r) { return __builtin_amdgcn_cosf(r); }
#define LDS_WAIT() asm volatile("s_waitcnt lgkmcnt(0)" ::: "memory")

namespace pg8 {
constexpr int BM = 256, BK = 64, HALF = 128, HTB = HALF * BK * 2, STAGE_BYTES = 8 * HTB, NXCD = 8, WGM = 4;
__host__ __device__ __forceinline__ int lds_byte(int r, int c) { const int st = (r >> 4) * 2 + (c >> 5), rr = r & 15, cc = c & 31, ob = rr * 64 + cc * 2; return st * 1024 + (ob ^ (((ob >> 9) & 1) << 5)); }
__host__ __device__ __forceinline__ void stage_rc(int b, int& R, int& C) { const int st = b / 1024, sb = b % 1024, swz = sb ^ (((sb >> 9) & 1) << 5); R = (st >> 1) * 16 + swz / 64; C = (st & 1) * 32 + (swz % 64) / 2; }
__host__ __device__ __forceinline__ int perm32(int rho) { const int n = rho >> 4, i = rho & 15; return 8 * (i >> 2) + 4 * n + (i & 3); }
struct Unit { int pm, pn; };
struct Gemm { const bf16_t* A; const bf16_t* Bt; int M, N, K, lda, ldb, apn_mul; };
struct StaticOrder {
    int nM, nN, nwg, G, c;
    __host__ __device__ void init(int M, int N, int G_, int c_) { nM = M / BM; nN = N / BM; nwg = nM * nN; G = G_; c = c_; }
    __host__ __device__ bool next(int i, Unit& u) const {
        const long Lx = (long)i * G + c; if (Lx >= nwg) return false;
        int wgid = (int)Lx; { const int q = nwg / NXCD, r = nwg % NXCD, xcd = wgid % NXCD, off = wgid / NXCD; wgid = (xcd < r ? xcd * (q + 1) : r * (q + 1) + (xcd - r) * q) + off; }
        const int nig = WGM * nN, gid = wgid / nig, fm = gid * WGM, gsz = (nM - fm) < WGM ? (nM - fm) : WGM;
        u.pm = fm + ((wgid % nig) % gsz); u.pn = (wgid % nig) / gsz; return true;
    }
};

template <bool SQRELU> struct EpiRowScaleBf16 {
    static constexpr bool PERM = true;
    bf16_t* O; int ldc; const float* rs;
    __device__ __forceinline__ void operator()(const f32x4 (&acc)[2][2][4][2], const Unit& u, int wr, int wc, int fr, int fq) const {
        const int row0 = u.pm * BM + wr * 64 + fr, col0 = u.pn * BM + wc * 32 + 8 * fq;
#pragma unroll
        for (int ai = 0; ai < 2; ++ai)
#pragma unroll
            for (int m = 0; m < 4; ++m) { const int row = row0 + ai * HALF + m * 16; const float r = rs[row]; bf16_t* rowp = O + (size_t)row * ldc + col0;
#pragma unroll
                for (int bj = 0; bj < 2; ++bj) { f32x4 v0 = acc[ai][bj][m][0] * r, v1 = acc[ai][bj][m][1] * r;
                    if (SQRELU) {
#pragma unroll
                        for (int j = 0; j < 4; ++j) { float a = fmaxf(v0[j], 0.f), b = fmaxf(v1[j], 0.f); v0[j] = a * a; v1[j] = b * b; } }
                    u32x4 w; w.x = pk2(v0[0], v0[1]); w.y = pk2(v0[2], v0[3]); w.z = pk2(v1[0], v1[1]); w.w = pk2(v1[2], v1[3]);
                    *(u32x4*)(rowp + bj * HALF) = w; } }
    }
};
struct EpiF32SS {
    static constexpr bool PERM = false;
    float* C; int ldc; const float* cs; float* sspart;
    __device__ __forceinline__ void operator()(const f32x4 (&acc)[2][2][4][2], const Unit& u, int wr, int wc, int fr, int fq) const {
        const int row0 = u.pm * BM + wr * 64 + fr, col0 = u.pn * BM + wc * 32 + 4 * fq;
        f32x4 sv[2][2];
#pragma unroll
        for (int bj = 0; bj < 2; ++bj)
#pragma unroll
            for (int n = 0; n < 2; ++n) sv[bj][n] = cs ? *(const f32x4*)(cs + col0 + bj * HALF + n * 16) : (f32x4){1.f, 1.f, 1.f, 1.f};
#pragma unroll
        for (int ai = 0; ai < 2; ++ai)
#pragma unroll
            for (int m = 0; m < 4; ++m) { const int row = row0 + ai * HALF + m * 16; float* rowp = C + (size_t)row * ldc + col0; float s = 0.f;
#pragma unroll
                for (int bj = 0; bj < 2; ++bj)
#pragma unroll
                    for (int n = 0; n < 2; ++n) { const f32x4 v = acc[ai][bj][m][n] * sv[bj][n]; *(f32x4*)(rowp + bj * HALF + n * 16) = v; s += (v[0] * v[0] + v[1] * v[1]) + (v[2] * v[2] + v[3] * v[3]); }
                s += __shfl_xor(s, 16); s += __shfl_xor(s, 32);
                if (fq == 0) sspart[(size_t)row * 32 + u.pn * 4 + wc] = s; }
    }
};

template <class Epi, bool ALIGN_EPI = false, bool FUSED = false>
__device__ __forceinline__ bool gemm_phase(LAS unsigned char* lds, const Gemm g, const StaticOrder& S, const Epi& E, f32x4 (&acc)[2][2][4][2], Unit& cur) {
    const int tid = threadIdx.x, wid = __builtin_amdgcn_readfirstlane(tid >> 6), lane = tid & 63, wr = wid >> 2, wc = wid & 3, fr = lane & 15, fq = lane >> 4;
    const int K = g.K, nt = K / BK;
    unsigned voffA[2], voffB[2];
#pragma unroll
    for (int i = 0; i < 2; ++i) { int R, C; stage_rc(tid * 16 + i * 8192, R, C); const int Rb = Epi::PERM ? ((R & ~31) + perm32(R & 31)) : R;
        voffA[i] = (unsigned)(R * g.lda + C) * 2u; voffB[i] = (unsigned)(Rb * g.ldb + C) * 2u; }
    const size_t kstep = (size_t)(BK * 2);
    const size_t hstepA = (size_t)HALF * g.lda * 2, hstepB = (size_t)HALF * g.ldb * 2;
    const size_t tstepA = 2 * hstepA, tstepB = 2 * hstepB;
    const unsigned ldsw = (unsigned)wid * 1024u;
    const int aoff = lds_byte(wr * 64 + fr, fq * 8), boff = lds_byte(wc * 32 + fr, fq * 8);
#define PG8_SA(b, h) (((b) * 2 + (h)) * HTB)
#define PG8_SB(b, h) ((4 + (b) * 2 + (h)) * HTB)
#define PG8_STAGE(bufoff, gbase, voff) do { _Pragma("unroll") for (int _i = 0; _i < 2; ++_i) \
        __builtin_amdgcn_global_load_lds((const unsigned*)((const char*)(gbase) + (voff)[_i]), (LAS unsigned*)(lds + (bufoff) + ldsw + _i * 8192), 16, 0, 0); } while (0)
#define PG8_LDA(dst, b, h) do { _Pragma("unroll") for (int m = 0; m < 4; ++m) _Pragma("unroll") for (int k = 0; k < 2; ++k) dst[m][k] = *(const LAS bf16x8*)(lds + PG8_SA(b, h) + aoff + m * 2048 + k * 1024); } while (0)
#define PG8_LDB(dst, b, h) do { _Pragma("unroll") for (int n = 0; n < 2; ++n) _Pragma("unroll") for (int k = 0; k < 2; ++k) dst[n][k] = *(const LAS bf16x8*)(lds + PG8_SB(b, h) + boff + n * 2048 + k * 1024); } while (0)
#define PG8_MMA(ai, bj, At, Bt) do { __builtin_amdgcn_s_setprio(1); _Pragma("unroll") for (int m = 0; m < 4; ++m) _Pragma("unroll") for (int n = 0; n < 2; ++n) _Pragma("unroll") for (int k = 0; k < 2; ++k) \
        acc[ai][bj][m][n] = __builtin_amdgcn_mfma_f32_16x16x32_bf16(Bt[n][k], At[m][k], acc[ai][bj][m][n], 0, 0, 0); __builtin_amdgcn_s_setprio(0); } while (0)
#define PG8_WAIT_V(n) asm volatile("s_waitcnt vmcnt(" #n ")" ::: "memory")
#define PG8_WAIT_L(n) asm volatile("s_waitcnt lgkmcnt(" #n ")" ::: "memory")
#define PG8_BAR __builtin_amdgcn_s_barrier()
#define PG8_SCHED __builtin_amdgcn_sched_barrier(0)
    Unit nxt; int ui = 0;
    if (!S.next(0, cur)) return false;
#pragma unroll
    for (int a = 0; a < 2; ++a)
#pragma unroll
        for (int b = 0; b < 2; ++b)
#pragma unroll
            for (int m = 0; m < 4; ++m)
#pragma unroll
                for (int n = 0; n < 2; ++n) acc[a][b][m][n] = (f32x4){0.f, 0.f, 0.f, 0.f};
    bf16x8 At[4][2], B0[2][2], B1[2][2];
    const char* cA = (const char*)g.A + (size_t)cur.pm * tstepA + (size_t)((cur.pn >> 1) * g.apn_mul) * 2; const char* cB = (const char*)g.Bt + (size_t)cur.pn * tstepB;
    PG8_STAGE(PG8_SB(0, 0), cB, voffB); PG8_STAGE(PG8_SB(0, 1), cB + hstepB, voffB); PG8_STAGE(PG8_SA(0, 0), cA, voffA); PG8_STAGE(PG8_SA(0, 1), cA + hstepA, voffA);
    if (wr == 1) PG8_BAR;
    PG8_WAIT_V(2); PG8_BAR;
    PG8_STAGE(PG8_SB(1, 0), cB + kstep, voffB); PG8_STAGE(PG8_SA(1, 0), cA + kstep, voffA); PG8_STAGE(PG8_SB(1, 1), cB + hstepB + kstep, voffB);
    PG8_WAIT_V(6); PG8_BAR;
    for (;;) {
        const bool has_next = S.next(ui + 1, nxt);
        const char* nA = has_next ? (const char*)g.A + (size_t)nxt.pm * tstepA + (size_t)((nxt.pn >> 1) * g.apn_mul) * 2 : cA; const char* nB = has_next ? (const char*)g.Bt + (size_t)nxt.pn * tstepB : cB;
        for (int t = 0; t < nt; t += 2) {
            const bool last = (t == nt - 2);
            const char* a1 = cA + (size_t)(t + 1) * kstep;
            const char* a2 = last ? nA : cA + (size_t)(t + 2) * kstep; const char* b2 = last ? nB : cB + (size_t)(t + 2) * kstep;
            const char* a3 = a2 + kstep; const char* b3 = b2 + kstep;
            PG8_LDB(B0, 0, 0); PG8_LDB(B1, 0, 1); PG8_SCHED; PG8_LDA(At, 0, 0); PG8_STAGE(PG8_SA(1, 1), a1 + hstepA, voffA);
            PG8_WAIT_V(8); PG8_WAIT_L(0); PG8_BAR; PG8_MMA(0, 0, At, B0); PG8_MMA(0, 1, At, B1); PG8_BAR; PG8_SCHED;
            PG8_LDA(At, 0, 1); PG8_STAGE(PG8_SB(0, 0), b2, voffB); PG8_STAGE(PG8_SB(0, 1), b2 + hstepB, voffB); PG8_STAGE(PG8_SA(0, 0), a2, voffA);
            PG8_WAIT_V(8); PG8_WAIT_L(0); PG8_BAR; PG8_MMA(1, 0, At, B0); PG8_MMA(1, 1, At, B1); PG8_BAR; PG8_SCHED;
            PG8_LDB(B0, 1, 0); PG8_LDB(B1, 1, 1); PG8_SCHED; PG8_LDA(At, 1, 0); PG8_STAGE(PG8_SA(0, 1), a2 + hstepA, voffA);
            PG8_WAIT_V(8); PG8_WAIT_L(0); PG8_BAR; PG8_MMA(0, 0, At, B0); PG8_MMA(0, 1, At, B1); PG8_BAR; PG8_SCHED;
            PG8_LDA(At, 1, 1); PG8_STAGE(PG8_SB(1, 0), b3, voffB); PG8_STAGE(PG8_SB(1, 1), b3 + hstepB, voffB); PG8_STAGE(PG8_SA(1, 0), a3, voffA);
            PG8_WAIT_V(8); PG8_WAIT_L(0); PG8_BAR; PG8_MMA(1, 0, At, B0); PG8_MMA(1, 1, At, B1); PG8_BAR; PG8_SCHED;
        }
        if constexpr (ALIGN_EPI) { if (wr == 0) PG8_BAR; }
        if constexpr (!FUSED) E(acc, cur, wr, wc, fr, fq);
        if (!has_next) break;
#pragma unroll
        for (int a = 0; a < 2; ++a)
#pragma unroll
            for (int b = 0; b < 2; ++b)
#pragma unroll
                for (int m = 0; m < 4; ++m)
#pragma unroll
                    for (int n = 0; n < 2; ++n) acc[a][b][m][n] = (f32x4){0.f, 0.f, 0.f, 0.f};
        cur = nxt; cA = nA; cB = nB; ++ui;
        if constexpr (ALIGN_EPI) { if (wr == 1) PG8_BAR; }
    }
    PG8_WAIT_V(0);
    if constexpr (!ALIGN_EPI) { if (wr == 0) PG8_BAR; }
    PG8_BAR;
    return true;
#undef PG8_SA
#undef PG8_SB
#undef PG8_STAGE
#undef PG8_LDA
#undef PG8_LDB
#undef PG8_MMA
#undef PG8_WAIT_V
#undef PG8_WAIT_L
#undef PG8_BAR
#undef PG8_SCHED
}
}

__device__ __forceinline__ void transpose_item(const float* __restrict__ W, int N, bf16_t* WT, int ldt, int row_off, const float* __restrict__ gs, LAS float* scr, int item, int lane, bool late = false) {
    const int nblk = N / 64, kb = item / nblk, nb = item % nblk, k0 = 64 * kb, n0 = 64 * nb;
    const int ks = lane >> 4, n4 = lane & 15;
    f32x4 v[16];
#pragma unroll
    for (int i = 0; i < 16; ++i) v[i] = __builtin_nontemporal_load((const f32x4*)(W + (size_t)(k0 + 4 * i + ks) * N + n0 + 4 * n4));
    if (gs) {
#pragma unroll
        for (int i = 0; i < 16; ++i) v[i] = v[i] * gs[k0 + 4 * i + ks];
    }
#pragma unroll
    for (int i = 0; i < 16; ++i) { const int k = 4 * i + ks; scr[(4 * n4 + 0) * 65 + k] = v[i].x; scr[(4 * n4 + 1) * 65 + k] = v[i].y; scr[(4 * n4 + 2) * 65 + k] = v[i].z; scr[(4 * n4 + 3) * 65 + k] = v[i].w; }
    LDS_WAIT();
    const int c = lane & 7;
#pragma unroll
    for (int j = 0; j < 8; ++j) { const int n = (lane >> 3) + 8 * j; const LAS float* sp = scr + n * 65 + 8 * c;
        u32x4 o; o.x = pk2(sp[0], sp[1]); o.y = pk2(sp[2], sp[3]); o.z = pk2(sp[4], sp[5]); o.w = pk2(sp[6], sp[7]);
        if (late) __builtin_nontemporal_store(o, (u32x4*)(WT + (size_t)(row_off + n0 + n) * ldt + k0 + 8 * c)); else *(u32x4*)(WT + (size_t)(row_off + n0 + n) * ldt + k0 + 8 * c) = o; }
    LDS_WAIT();
}

typedef f32x2 cf;
__device__ __forceinline__ int PADI(int i) { return i + ((i >> 6) << 2); }
__device__ __forceinline__ cf cmul(cf a, cf b) { return (cf){a.x * b.x - a.y * b.y, a.x * b.y + a.y * b.x}; }
template <int SIGN> __device__ __forceinline__ void dft4(cf& a, cf& b, cf& c, cf& d) {
    const cf s0 = a + c, s1 = a - c, s2 = b + d, s3 = b - d;
    a = s0 + s2; c = s0 - s2;
    if (SIGN < 0) { b = (cf){s1.x + s3.y, s1.y - s3.x}; d = (cf){s1.x - s3.y, s1.y + s3.x}; }
    else          { b = (cf){s1.x - s3.y, s1.y + s3.x}; d = (cf){s1.x + s3.y, s1.y - s3.x}; }
}
template <int SIGN> __device__ __forceinline__ cf mulw(cf x, float c, float s) { return cmul(x, (cf){c, SIGN * s}); }
template <int SIGN> __device__ __forceinline__ void dft16(cf (&x)[16]) {
#pragma unroll
    for (int n2 = 0; n2 < 4; ++n2) dft4<SIGN>(x[n2], x[4 + n2], x[8 + n2], x[12 + n2]);
    constexpr float C1 = 0.92387953251f, S1 = 0.38268343236f, C2 = 0.70710678118f;
    x[5] = mulw<SIGN>(x[5], C1, S1); x[6] = mulw<SIGN>(x[6], C2, C2); x[7] = mulw<SIGN>(x[7], S1, C1);
    x[9] = mulw<SIGN>(x[9], C2, C2); x[10] = (SIGN < 0) ? (cf){x[10].y, -x[10].x} : (cf){-x[10].y, x[10].x}; x[11] = mulw<SIGN>(x[11], -C2, C2);
    x[13] = mulw<SIGN>(x[13], S1, C1); x[14] = mulw<SIGN>(x[14], -C2, C2); x[15] = mulw<SIGN>(x[15], -C1, -S1);
#pragma unroll
    for (int k1 = 0; k1 < 4; ++k1) dft4<SIGN>(x[4 * k1], x[4 * k1 + 1], x[4 * k1 + 2], x[4 * k1 + 3]);
}
template <int LOG2S, bool FWD> __device__ __forceinline__ void pass16(LAS cf* a, int tid) {
    constexpr int S = 1 << LOG2S, NC = 16 * S, PS = S + ((S >> 6) << 2);
#pragma unroll 1
    for (int r = 0; r < 2; ++r) {
        const int b = tid + 512 * r, j = b & (S - 1), blk = b >> LOG2S, base = blk * NC + j;
        LAS cf* ap = a + PADI(base);
        cf x[16];
#pragma unroll
        for (int k = 0; k < 16; ++k) x[k] = ap[k * PS];
        float jr = (float)j * (1.0f / NC);
        asm volatile("" : "+v"(jr));
        const cf w1 = {cos_rev(jr), FWD ? -sin_rev(jr) : sin_rev(jr)};
        cf w = w1;
        if (!FWD) {
#pragma unroll
            for (int k = 1; k < 16; ++k) { x[k] = cmul(x[k], w); if (k < 15) w = cmul(w, w1); }
            dft16<1>(x);
        } else {
            dft16<-1>(x);
#pragma unroll
            for (int k = 1; k < 16; ++k) { const int sl = 4 * (k & 3) + (k >> 2); x[sl] = cmul(x[sl], w); if (k < 15) w = cmul(w, w1); }
        }
#pragma unroll
        for (int k = 0; k < 16; ++k) ap[k * PS] = x[4 * (k & 3) + (k >> 2)];
    }
}
template <int SIGN> __device__ __forceinline__ void pass4(LAS cf* a, int tid) {
#pragma unroll 2
    for (int r = 0; r < 8; ++r) {
        const int p = PADI(4 * (tid + 512 * r));
        f32x4 u0 = *(LAS f32x4*)(a + p), u1 = *(LAS f32x4*)(a + p + 2);
        cf x0 = {u0.x, u0.y}, x1 = {u0.z, u0.w}, x2 = {u1.x, u1.y}, x3 = {u1.z, u1.w};
        dft4<SIGN>(x0, x1, x2, x3);
        *(LAS f32x4*)(a + p) = (f32x4){x0.x, x0.y, x1.x, x1.y}; *(LAS f32x4*)(a + p + 2) = (f32x4){x2.x, x2.y, x3.x, x3.y};
    }
}
__device__ __forceinline__ int fpos(int f) { return 1024 * (f & 15) + 64 * ((f >> 4) & 15) + 4 * ((f >> 8) & 15) + (f >> 12); }

struct RowBuf { f32x4 x[8], m[8]; float sp; };
__device__ __forceinline__ void row_load(RowBuf& b, const float* xin, const float* m, const float* sspart, int row, int lane) {
    const f32x4* xr = (const f32x4*)(xin + (size_t)row * D) + lane; const f32x4* mr = (const f32x4*)(m + (size_t)row * D) + lane;
    b.sp = (lane < 32) ? sspart[(size_t)row * 32 + lane] : 0.f;
#pragma unroll
    for (int j = 0; j < 8; ++j) { b.x[j] = xr[64 * j]; b.m[j] = mr[64 * j]; }
}
template <int MODE> __device__ __forceinline__ void row_compute(RowBuf& b, const f32x4 (&gv)[8], float* xout, bf16_t* bout, float* rnext, const float* __restrict__ gnext, int row, int lane) {
    const float rm = rsqrtf(wave_sum(b.sp) * (1.0f / D) + 1e-6f);
    float ss = 0.f;
    f32x4* xo = (f32x4*)(xout + (size_t)row * D) + lane;
#pragma unroll
    for (int j = 0; j < 8; ++j) { const f32x4 v = b.x[j] + b.m[j] * rm * gv[j]; b.x[j] = v; ss += (v.x * v.x + v.y * v.y) + (v.z * v.z + v.w * v.w); xo[64 * j] = v; }
    if (MODE != 2) {
        const float r = rsqrtf(wave_sum(ss) * (1.0f / D) + 1e-6f);
        u32x2* bo = (u32x2*)(bout + (size_t)row * D) + lane;
        if (MODE == 0) {
#pragma unroll
            for (int j = 0; j < 8; ++j) bo[64 * j] = (u32x2){pk2(b.x[j].x, b.x[j].y), pk2(b.x[j].z, b.x[j].w)};
            if (lane == 0) rnext[row] = r;
        } else {
            const f32x4* gn = (const f32x4*)gnext + lane;
#pragma unroll
            for (int j = 0; j < 8; ++j) { const f32x4 w = b.x[j] * r * gn[64 * j]; bo[64 * j] = (u32x2){pk2(w.x, w.y), pk2(w.z, w.w)}; }
        }
    }
}
template <int MODE> __device__ __forceinline__ void row_phase(const float* xin, const float* m, const float* sspart, const float* __restrict__ g, float* xout, bf16_t* bout, float* rnext, const float* __restrict__ gnext, int gw, int ngw, int lane) {
    if (gw >= L) return;
    f32x4 gv[8];
#pragma unroll
    for (int j = 0; j < 8; ++j) gv[j] = ((const f32x4*)g + lane)[64 * j];
    RowBuf A, B;
    row_load(A, xin, m, sspart, gw, lane);
    for (int row = gw; row < L; row += 2 * ngw) {
        const bool hasB = (row + ngw < L);
        if (hasB) row_load(B, xin, m, sspart, row + ngw, lane);
        row_compute<MODE>(A, gv, xout, bout, rnext, gnext, row, lane);
        if (row + 2 * ngw < L) row_load(A, xin, m, sspart, row + 2 * ngw, lane);
        if (hasB) row_compute<MODE>(B, gv, xout, bout, rnext, gnext, row + ngw, lane);
    }
}

#define XB_TMO      128
#define XB_XCNT(j)  (256  + 64 * (j))
#define XB_XSUB(j)  (1280 + 64 * (j))
#define XB_XGEN(j)  (2304 + 64 * (j))
#define XB_TOP      3328
#define XB_TOPGEN   3392
#define XCD_BAR_WORDS 3456
#define XB_SPIN_CAP (1u << 18)

__device__ __forceinline__ unsigned xb_ld(unsigned* p)              { return __hip_atomic_load(p, __ATOMIC_RELAXED, __HIP_MEMORY_SCOPE_AGENT); }
__device__ __forceinline__ unsigned xb_add(unsigned* p, unsigned v) { return __hip_atomic_fetch_add(p, v, __ATOMIC_RELAXED, __HIP_MEMORY_SCOPE_AGENT); }
__device__ __forceinline__ unsigned xb_xcc_id() { return (unsigned)__builtin_amdgcn_s_getreg((3 << 11) | 20) & 0xFu; }
#define XB_SPIN(cond, bar) do { unsigned _sp = 0; while (cond) { __builtin_amdgcn_s_sleep(1); \
    if ((++_sp & 255u) == 0u) { if (xb_ld(&(bar)[XB_TMO])) break; if (_sp > XB_SPIN_CAP) { atomicAdd(&(bar)[XB_TMO], 1u); break; } } } } while (0)

struct XcdBarrier {
    unsigned* bar; unsigned x;
    volatile LAS unsigned* st;
};

__device__ __forceinline__ XcdBarrier xcd_barrier_post(unsigned* bar, volatile LAS unsigned* st) {
    XcdBarrier b; b.bar = bar; b.x = xb_xcc_id(); b.st = st;
    if (threadIdx.x == 0) (void)xb_add(&bar[XB_XCNT(b.x)], 1u);
    return b;
}
__device__ __forceinline__ void xcd_barrier_complete(unsigned* bar, unsigned x, unsigned& nloc, unsigned& nx) {
    const unsigned G = gridDim.x * gridDim.y * gridDim.z;
    unsigned sum, cnt, mine, sp = 0u;
    for (;;) {
        sum = 0u; cnt = 0u; mine = 0u;
#pragma unroll
        for (unsigned j = 0; j < 16; ++j) { const unsigned c = xb_ld(&bar[XB_XCNT(j)]); sum += c; cnt += (c > 0u) ? 1u : 0u; mine = (j == x) ? c : mine; }
        if (sum == G) break;
        __builtin_amdgcn_s_sleep(1);
        if ((++sp & 255u) == 0u) { if (xb_ld(&bar[XB_TMO])) break; if (sp > XB_SPIN_CAP) { atomicAdd(&bar[XB_TMO], 1u); break; } }
    }
    nloc = mine > 0u ? mine : 1u; nx = cnt > 0u ? cnt : 1u;
}

__device__ __forceinline__ void xcd_barrier(const XcdBarrier& b) {
    asm volatile("s_waitcnt vmcnt(0)" ::: "memory");
    __syncthreads();
    if (threadIdx.x == 0) {
        unsigned* bar = b.bar;
        __builtin_amdgcn_s_waitcnt(0);
        unsigned nloc = b.st[0], nx = b.st[1];
        if (nloc == 0u) { xcd_barrier_complete(bar, b.x, nloc, nx); b.st[0] = nloc; b.st[1] = nx; }
        const unsigned old = xb_add(&bar[XB_XSUB(b.x)], 1u);
        const unsigned gen = old / nloc;
        if (old + 1u == (gen + 1u) * nloc) {
            __builtin_amdgcn_fence(__ATOMIC_RELEASE, "agent");
            asm volatile("s_waitcnt vmcnt(0)" ::: "memory");
            const unsigned og = xb_add(&bar[XB_TOP], 1u);
            const unsigned tg = og / nx;
            if (og + 1u == (tg + 1u) * nx) xb_add(&bar[XB_TOPGEN], 1u);
            else XB_SPIN(xb_ld(&bar[XB_TOPGEN]) == tg, bar);
            __builtin_amdgcn_fence(__ATOMIC_ACQUIRE, "agent");
            xb_add(&bar[XB_XGEN(b.x)], 1u);
            asm volatile("s_waitcnt vmcnt(0)" ::: "memory");
        } else {
            XB_SPIN(xb_ld(&bar[XB_XGEN(b.x)]) == gen, bar);
            __builtin_amdgcn_fence(__ATOMIC_ACQUIRE, "agent");
            asm volatile("s_waitcnt vmcnt(0)" ::: "memory");
        }
    }
    __syncthreads();
}


struct FusedArgs { const float* xin; float* xout; bf16_t* bout; float* rnext; const float* g; const float* gnext; const float* cs; float* ss1; float* ss2; };
__device__ __forceinline__ void panel_rms(const float* ss, int pm, LAS float* S, int tid) {
    const int r = tid >> 1, hf = tid & 1; const f32x4* p = (const f32x4*)(ss + (size_t)(pm * 256 + r) * 32 + hf * 16);
    const f32x4 a0 = p[0], a1 = p[1], a2 = p[2], a3 = p[3];
    float sm = ((a0.x + a0.y) + (a0.z + a0.w)) + ((a1.x + a1.y) + (a1.z + a1.w)) + ((a2.x + a2.y) + (a2.z + a2.w)) + ((a3.x + a3.y) + (a3.z + a3.w));
    sm += __shfl_xor(sm, 1);
    if (hf == 0) S[r] = rsqrtf(sm * (1.0f / D) + 1e-6f);
}
template <int MODE> __device__ __forceinline__ void fused_res_epilogue(f32x4 (&acc)[2][2][4][2], bool has, const pg8::Unit u, const FusedArgs& F, LAS float* S, const XcdBarrier& xbar, int tid) {
    const int lane = tid & 63, wid = __builtin_amdgcn_readfirstlane(tid >> 6), wr = wid >> 2, wc = wid & 3, fr = lane & 15, fq = lane >> 4;
    const int rowl0 = wr * 64 + fr, row0 = u.pm * 256 + rowl0, col0 = u.pn * 256 + wc * 32 + 8 * fq;
    if (has) {
        if (F.cs) {
#pragma unroll
            for (int bj = 0; bj < 2; ++bj)
#pragma unroll
                for (int n = 0; n < 2; ++n) { const f32x4 sv = *(const f32x4*)(F.cs + col0 + bj * 128 + n * 4);
#pragma unroll
                    for (int ai = 0; ai < 2; ++ai)
#pragma unroll
                        for (int m = 0; m < 4; ++m) acc[ai][bj][m][n] = acc[ai][bj][m][n] * sv; } }
#pragma unroll
        for (int ai = 0; ai < 2; ++ai)
#pragma unroll
            for (int m = 0; m < 4; ++m) { float sq = 0.f;
#pragma unroll
                for (int bj = 0; bj < 2; ++bj)
#pragma unroll
                    for (int n = 0; n < 2; ++n) { const f32x4 v = acc[ai][bj][m][n]; sq += (v[0] * v[0] + v[1] * v[1]) + (v[2] * v[2] + v[3] * v[3]); }
                sq += __shfl_xor(sq, 16); sq += __shfl_xor(sq, 32);
                if (fq == 0) F.ss1[(size_t)(row0 + ai * 128 + m * 16) * 32 + u.pn * 4 + wc] = sq; }
    }
    xcd_barrier(xbar);
    if (has) {
        panel_rms(F.ss1, u.pm, S, tid);
        __syncthreads();
        f32x4 gv[2][2];
#pragma unroll
        for (int bj = 0; bj < 2; ++bj)
#pragma unroll
            for (int n = 0; n < 2; ++n) gv[bj][n] = *(const f32x4*)(F.g + col0 + bj * 128 + n * 4);
#pragma unroll
        for (int ai = 0; ai < 2; ++ai) {
            f32x4 xv[4][2][2];
#pragma unroll
            for (int m = 0; m < 4; ++m) { const float* xr = F.xin + (size_t)(row0 + ai * 128 + m * 16) * D + col0;
#pragma unroll
                for (int bj = 0; bj < 2; ++bj)
#pragma unroll
                    for (int n = 0; n < 2; ++n) xv[m][bj][n] = *(const f32x4*)(xr + bj * 128 + n * 4); }
#pragma unroll
            for (int m = 0; m < 4; ++m) { const int rl = rowl0 + ai * 128 + m * 16, row = u.pm * 256 + rl; const float rm = S[rl]; float sq = 0.f;
                float* xo = F.xout + (size_t)row * D + col0;
#pragma unroll
                for (int bj = 0; bj < 2; ++bj)
#pragma unroll
                    for (int n = 0; n < 2; ++n) { const int co = bj * 128 + n * 4;
                        const f32x4 v = xv[m][bj][n] + acc[ai][bj][m][n] * rm * gv[bj][n]; acc[ai][bj][m][n] = v; *(f32x4*)(xo + co) = v;
                        sq += (v[0] * v[0] + v[1] * v[1]) + (v[2] * v[2] + v[3] * v[3]); }
                if (MODE != 2) { sq += __shfl_xor(sq, 16); sq += __shfl_xor(sq, 32);
                    if (fq == 0) F.ss2[(size_t)row * 32 + u.pn * 4 + wc] = sq; } }
        }
    }
    if (MODE == 2) return;
    xcd_barrier(xbar);
    if (has) {
        panel_rms(F.ss2, u.pm, S, tid);
        __syncthreads();
#pragma unroll
        for (int ai = 0; ai < 2; ++ai)
#pragma unroll
            for (int m = 0; m < 4; ++m) { const int rl = rowl0 + ai * 128 + m * 16, row = u.pm * 256 + rl; const float r = S[rl];
                bf16_t* bo = F.bout + (size_t)row * D + col0;
                if (MODE == 0 && u.pn == 0 && wc == 0 && fq == 0) F.rnext[row] = r;
#pragma unroll
                for (int bj = 0; bj < 2; ++bj)
                    { f32x4 v0 = acc[ai][bj][m][0], v1 = acc[ai][bj][m][1];
                        if (MODE == 1) { v0 = v0 * r * *(const f32x4*)(F.gnext + col0 + bj * 128); v1 = v1 * r * *(const f32x4*)(F.gnext + col0 + bj * 128 + 4); }
                        *(u32x4*)(bo + bj * 128) = (u32x4){pk2(v0[0], v0[1]), pk2(v0[2], v0[3]), pk2(v1[0], v1[1]), pk2(v1[2], v1[3])}; } }
    }
}

struct Args { const float* in[19]; float* out; unsigned char* ws; int ph_lo, ph_hi; };

__global__ void __launch_bounds__(512, 2) fwd_kernel(Args a) {
    extern __shared__ __attribute__((aligned(16))) unsigned char smem[];
    LAS unsigned char* lds = (LAS unsigned char*)smem;
    const int tid = threadIdx.x, lane = tid & 63, wave = __builtin_amdgcn_readfirstlane(tid >> 6);
    const int G = gridDim.x, bid = blockIdx.x, gw = bid * 8 + wave, NGW = G * 8;
    unsigned char* ws = a.ws;
    const float* x = a.in[0]; const float* norm_g = a.in[1];
    bf16_t* Wt_in = (bf16_t*)(ws + WS_WIN); bf16_t* Wt_out = (bf16_t*)(ws + WS_WOUT); bf16_t* Wt_1 = (bf16_t*)(ws + WS_W1); bf16_t* Wt_2 = (bf16_t*)(ws + WS_W2); bf16_t* Wt_pool = (bf16_t*)(ws + WS_WPOOL);
    float* rA = (float*)(ws + WS_SMALL); float* hid2 = (float*)(ws + WS_SMALL + 1 * MiB); float* sspart = (float*)(ws + WS_SMALL + 3 * MiB); float* sspart2 = (float*)(ws + WS_SMALL + 128 * 1024);
    bf16_t* abuf = (bf16_t*)(ws + WS_ABUF);
    bf16_t* x0T = (bf16_t*)(ws + WS_ABUF2); bf16_t* yaT = (bf16_t*)(ws + WS_ABUF2 + 16 * MiB); bf16_t* hb = (bf16_t*)(ws + WS_ABUF2);
    float* KT = (float*)(ws + WS_M); float* mbuf = (float*)(ws + WS_M);
    bf16_t* Z = (bf16_t*)(ws + WS_H); float* uT = (float*)(ws + WS_H + 96 * MiB); bf16_t* hmid = (bf16_t*)(ws + WS_H);
    float* xres = a.out;
    cg::grid_group grid = cg::this_grid();
    const int lo = a.ph_lo, hi = a.ph_hi;
#ifndef PHMASK
#define PHMASK 0xFFFF
#endif
#define IN(k) (((PHMASK >> (k)) & 1) && lo <= (k) && (k) < hi)
#define SEAM(k) do { if (IN(k) && IN((k) + 1)) { if (a.ph_hi > NPHASE) grid.sync(); xcd_barrier(xbar); } } while (0)
    {   volatile LAS unsigned* st = (volatile LAS unsigned*)(lds + FFT_LDS_BYTES);
        if (tid < 16) st[tid] = 0u;
        __syncthreads(); }
    const XcdBarrier xbar = xcd_barrier_post((unsigned*)(ws + WS_CTL), (volatile LAS unsigned*)(lds + FFT_LDS_BYTES));

    if (IN(0)) {
        LAS float* scr = (LAS float*)(lds + wave * 16640);
        constexpr int I_IN = 32 * 96, I_OUT = 32 * 32, I_1 = 32 * 128, I_2 = 128 * 32, I_P = 8 * 8;
        constexpr int NITEMS = I_IN + I_OUT + 2 * I_1 + 2 * I_2 + 4 * I_P;
        for (int it = gw; it < NITEMS; it += NGW) {
            int r = it;
            if (r < I_IN) { transpose_item(a.in[2], DIN, Wt_in, D, 0, norm_g + 0 * D, scr, r, lane); continue; } r -= I_IN;
            if (r < I_OUT) { transpose_item(a.in[14], D, Wt_out, D, 0, nullptr, scr, r, lane); continue; } r -= I_OUT;
            if (r < 2 * I_1) { const int l = r / I_1; transpose_item(a.in[17] + (size_t)l * D * DFF, DFF, Wt_1 + (size_t)l * DFF * D, D, 0, norm_g + (l * 4 + 2) * D, scr, r % I_1, lane, l == 1); continue; } r -= 2 * I_1;
            if (r < 2 * I_2) { const int l = r / I_2; transpose_item(a.in[18] + (size_t)l * DFF * D, D, Wt_2 + (size_t)l * D * DFF, DFF, 0, nullptr, scr, r % I_2, lane, l == 1); continue; } r -= 2 * I_2;
            { const int gq = r / I_P; transpose_item(a.in[15] + (size_t)gq * 512 * 512, 512, Wt_pool, 512, gq * 512, nullptr, scr, r % I_P, lane); }
        }
        for (int row = gw; row < L; row += NGW) {
            const f32x4* xr = (const f32x4*)(x + (size_t)row * D) + lane; u32x2* bo = (u32x2*)(abuf + (size_t)row * D) + lane; float ss = 0.f;
#pragma unroll
            for (int j = 0; j < 8; ++j) { const f32x4 v = __builtin_nontemporal_load(xr + 64 * j); ss += (v.x * v.x + v.y * v.y) + (v.z * v.z + v.w * v.w); bo[64 * j] = (u32x2){pk2(v.x, v.y), pk2(v.z, v.w)}; }
            const float r = rsqrtf(wave_sum(ss) * (1.0f / D) + 1e-6f);
            if (lane == 0) rA[row] = r;
        }
        {
            const float* w1 = a.in[5]; const float* b1 = a.in[6]; const float* w2 = a.in[7]; const float* b2 = a.in[8]; const float fr = a.in[11][lane];
            for (int t = gw; t < L; t += NGW) {
                const int e = lane; float val;
                {   const int b = (e >= 17) ? (e - 17) : (e - 1);
                    const float band = 1e-4f + (float)b * ((15.0f - 1e-4f) / 15.0f);
                    float rev = ((float)t * (1.0f / 8192.0f)) * band; rev -= floorf(rev);
                    val = (e == 0) ? (float)t * (1.0f / 8191.0f) : ((e <= 16) ? cos_rev(rev) : -sin_rev(rev)); }
                float z1 = b1[lane];
#pragma unroll
                for (int i = 0; i < 33; ++i) z1 += __int_as_float(__builtin_amdgcn_readlane(__float_as_int(val), i)) * w1[i * 64 + lane];
                const float h1 = sin_rev(fr * z1 * 0.15915494309189535f);
                float z2 = b2[lane];
#pragma unroll
                for (int i = 0; i < 64; ++i) z2 += __int_as_float(__builtin_amdgcn_readlane(__float_as_int(h1), i)) * w2[i * 64 + lane];
                hid2[(size_t)t * 64 + lane] = sin_rev(fr * z2 * 0.15915494309189535f);
            }
        }
    }
    SEAM(0);

    if (IN(1)) {
        {
            typedef float f32x16 __attribute__((ext_vector_type(16)));
            const float* w3 = a.in[9]; const float* b3 = a.in[10];
            const int cl = lane & 31, h = lane >> 5;
            auto split8 = [](const float (&v)[8], bf16x8& hi, bf16x8& lo) {
                u32x4 hw, lw; unsigned hh[4], ll[4];
#pragma unroll
                for (int i = 0; i < 4; ++i) { hh[i] = pk2(v[2 * i], v[2 * i + 1]); ll[i] = pk2(v[2 * i] - bf_lo(hh[i]), v[2 * i + 1] - bf_hi(hh[i])); }
                hw = (u32x4){hh[0], hh[1], hh[2], hh[3]}; lw = (u32x4){ll[0], ll[1], ll[2], ll[3]};
                hi = __builtin_bit_cast(bf16x8, hw); lo = __builtin_bit_cast(bf16x8, lw); };
            for (int it = gw; it < 64 * 64; it += NGW) {
                const int cb = it >> 6, tq = it & 63, c0 = cb * 32;
                bf16x8 ahi[4], alo[4];
#pragma unroll
                for (int sidx = 0; sidx < 4; ++sidx) { float av[8];
#pragma unroll
                    for (int e = 0; e < 8; ++e) av[e] = w3[(size_t)(16 * sidx + 8 * h + e) * 2048 + c0 + cl];
                    split8(av, ahi[sidx], alo[sidx]); }
                constexpr float DMIN = -3.0701134573253943f, DMAX = -15.350567286626972f;
#pragma unroll 1
                for (int q = 0; q < 4; ++q) {
                    const int tg = tq * 128 + q * 32 + cl;
                    f32x4 bv[8];
#pragma unroll
                    for (int i = 0; i < 8; ++i) bv[i] = *(const f32x4*)(hid2 + (size_t)tg * 64 + 16 * (i >> 1) + 8 * h + 4 * (i & 1));
                    f32x16 acc = {0.f, 0.f, 0.f, 0.f, 0.f, 0.f, 0.f, 0.f, 0.f, 0.f, 0.f, 0.f, 0.f, 0.f, 0.f, 0.f};
#pragma unroll
                    for (int sidx = 0; sidx < 4; ++sidx) { const float bvv[8] = {bv[2 * sidx].x, bv[2 * sidx].y, bv[2 * sidx].z, bv[2 * sidx].w, bv[2 * sidx + 1].x, bv[2 * sidx + 1].y, bv[2 * sidx + 1].z, bv[2 * sidx + 1].w};
                        bf16x8 bhi, blo; split8(bvv, bhi, blo);
                        acc = __builtin_amdgcn_mfma_f32_32x32x16_bf16(alo[sidx], bhi, acc, 0, 0, 0);
                        acc = __builtin_amdgcn_mfma_f32_32x32x16_bf16(ahi[sidx], blo, acc, 0, 0, 0);
                        acc = __builtin_amdgcn_mfma_f32_32x32x16_bf16(ahi[sidx], bhi, acc, 0, 0, 0); }
                    const float tl = (float)tg * (1.0f / 8191.0f);
                    int zoff = 0; asm volatile("" : "+v"(zoff));
#pragma unroll
                    for (int i = 0; i < 16; ++i) { const int c = c0 + 8 * (i >> 2) + 4 * h + (i & 3) + zoff, ch = c & 1023;
                        const float dlt = fabsf(DMIN + (float)ch * ((DMAX - DMIN) / 1023.0f));
                        const float val = (acc[i] + b3[c]) * __expf(-tl * dlt);
                        if (c < 1024) KT[(size_t)ch * NFFT + tg] = val;
                        else { if (tg >= 1) KT[(size_t)ch * NFFT + (NFFT - tg)] = val; else KT[(size_t)ch * NFFT + 8192] = 0.f; } }
                }
            }
        }
            { pg8::Gemm g{abuf, Wt_in, L, DIN, D, D, D, 0}; pg8::StaticOrder S; S.init(L, DIN, G, bid);
          pg8::EpiRowScaleBf16<false> E{Z, DIN, rA};
          f32x4 acc[2][2][4][2]; pg8::Unit cu; pg8::gemm_phase<pg8::EpiRowScaleBf16<false>, true>(lds, g, S, E, acc, cu); }
    }
    SEAM(1);

    if (IN(2)) {
        const float* hw = a.in[3]; const float* hbias = a.in[4]; const float* scw = a.in[13];
        bf16_t* ycat = abuf;
        LAS float* wl = (LAS float*)lds;
        LAS float* sbuf = (LAS float*)(lds + 4096);
        const int tt = tid >> 3, cg8 = tid & 7;
        const u32x4 zero4 = {0u, 0u, 0u, 0u};
        {
            u32x4 zr[3][3]; int cur_cb = -1, par = 0;
            auto issue = [&](int it) { const int tb = it >> 4, cb = it & 15, t = tb * 64 + tt, c8 = cb * 64 + cg8 * 8;
#pragma unroll
                for (int s3 = 0; s3 < 3; ++s3)
#pragma unroll
                    for (int d = 0; d < 3; ++d) { const int tr = t + d - 1; zr[s3][d] = (tr >= 0 && tr < L) ? *(const u32x4*)(Z + (size_t)tr * DIN + s3 * 1024 + c8) : zero4; } };
            if (bid < 2048) issue(bid);
            for (int it = bid; it < 2048; it += G, par ^= 1) {
                const int tb = it >> 4, cb = it & 15;
                if (cb != cur_cb) {
                    __syncthreads();
                    for (int i = tid; i < 768; i += 512) { const int rw = i >> 6, ch = i & 63, s3 = rw >> 2, k = rw & 3; wl[i] = (k < 3) ? hw[k * 3072 + s3 * 1024 + cb * 64 + ch] : hbias[s3 * 1024 + cb * 64 + ch]; }
                    __syncthreads(); cur_cb = cb; }
                float hy[3][8];
#pragma unroll
                for (int s3 = 0; s3 < 3; ++s3) { float zm[8], z0[8], zp[8]; unpack8(zr[s3][0], zm); unpack8(zr[s3][1], z0); unpack8(zr[s3][2], zp);
                    float w0[8], w1[8], w2[8], bb[8];
#pragma unroll
                    for (int hq = 0; hq < 2; ++hq) { const f32x4 a0 = *(LAS f32x4*)(wl + (4 * s3 + 0) * 64 + cg8 * 8 + 4 * hq), a1 = *(LAS f32x4*)(wl + (4 * s3 + 1) * 64 + cg8 * 8 + 4 * hq), a2 = *(LAS f32x4*)(wl + (4 * s3 + 2) * 64 + cg8 * 8 + 4 * hq), a3 = *(LAS f32x4*)(wl + (4 * s3 + 3) * 64 + cg8 * 8 + 4 * hq);
#pragma unroll
                        for (int j = 0; j < 4; ++j) { w0[4 * hq + j] = a0[j]; w1[4 * hq + j] = a1[j]; w2[4 * hq + j] = a2[j]; bb[4 * hq + j] = a3[j]; } }
#pragma unroll
                    for (int i = 0; i < 8; ++i) hy[s3][i] = w0[i] * zm[i] + w1[i] * z0[i] + w2[i] * zp[i] + bb[i]; }
                if (it + G < 2048) issue(it + G);
                LAS float* su = sbuf + par * (2 * 64 * 65); LAS float* sx = su + 64 * 65;
#pragma unroll
                for (int i = 0; i < 8; ++i) { su[(cg8 * 8 + i) * 65 + tt] = hy[2][i] * hy[1][i]; sx[(cg8 * 8 + i) * 65 + tt] = hy[0][i]; }
                __syncthreads();
                const int c = tid >> 3, ch = tid & 7;
                float uo[8], xo[8];
#pragma unroll
                for (int i = 0; i < 8; ++i) { uo[i] = su[c * 65 + ch * 8 + i]; xo[i] = sx[c * 65 + ch * 8 + i]; }
                float* up = uT + (size_t)(cb * 64 + c) * L + tb * 64 + ch * 8;
                *(f32x4*)up = (f32x4){uo[0], uo[1], uo[2], uo[3]}; *(f32x4*)(up + 4) = (f32x4){uo[4], uo[5], uo[6], uo[7]};
                *(u32x4*)(x0T + (size_t)(cb * 64 + c) * L + tb * 64 + ch * 8) = pack8(xo);
            }
        }
        {
            u32x4 rg, rc[3], rx[3];
            auto issue = [&](int it) { const int tb = it >> 4, cb = it & 15, t = tb * 64 + tt, c8 = cb * 64 + cg8 * 8;
                rg = *(const u32x4*)(Z + (size_t)t * DIN + 3072 + c8);
#pragma unroll
                for (int d = 0; d < 3; ++d) { const int tr = t + d - 1; const bool ok = (tr >= 0 && tr < L);
                    rc[d] = ok ? *(const u32x4*)(Z + (size_t)tr * DIN + 4096 + c8) : zero4; rx[d] = ok ? *(const u32x4*)(Z + (size_t)tr * DIN + 5120 + c8) : zero4; } };
            if (bid < 2048) issue(bid);
            for (int it = bid; it < 2048; it += G) {
                const int tb = it >> 4, cb = it & 15, t = tb * 64 + tt, c8 = cb * 64 + cg8 * 8;
                float gb[8], p[3][8];
                unpack8(rg, gb);
#pragma unroll
                for (int d = 0; d < 3; ++d) { float gc[8], xv[8]; unpack8(rc[d], gc); unpack8(rx[d], xv);
#pragma unroll
                    for (int i = 0; i < 8; ++i) p[d][i] = gc[i] * xv[i]; }
                if (it + G < 2048) issue(it + G);
                float yb[8];
#pragma unroll
                for (int i = 0; i < 8; ++i) yb[i] = gb[i] * (scw[c8 + i] * p[0][i] + scw[1024 + c8 + i] * p[1][i] + scw[2048 + c8 + i] * p[2][i]);
                *(u32x4*)(ycat + (size_t)t * D + 1024 + c8) = pack8(yb);
            }
        }
    }
    SEAM(2);

    if (IN(3)) {
        LAS cf* fa = (LAS cf*)lds; const float* hyb = a.in[12];
        f32x4 pkv[8], puv[4];
        if (bid < DHY) { const float* up0 = uT + (size_t)bid * L; const float* kp0 = KT + (size_t)bid * NFFT;
#pragma unroll
            for (int r = 0; r < 8; ++r) pkv[r] = __builtin_nontemporal_load((const f32x4*)(kp0 + 4 * (tid + 512 * r)));
#pragma unroll
            for (int r = 0; r < 4; ++r) puv[r] = *(const f32x4*)(up0 + 4 * (tid + 512 * r)); }
        cf Yr[16]; float Yh = 0.f; int kidx = 0;
        for (int c = bid; c < DHY; c += G, ++kidx) {
            const bool second = (kidx & 1) != 0, hold = (!second && (c + G < DHY));
            __syncthreads();
#pragma unroll
            for (int r = 0; r < 8; ++r) { const int n = 4 * (tid + 512 * r);
                const f32x4 kv = pkv[r]; const f32x4 uv = (r < 4) ? puv[r & 3] : (f32x4){0.f, 0.f, 0.f, 0.f};
                const int p = PADI(n);
                *(LAS f32x4*)(fa + p) = (f32x4){uv.x, kv.x, uv.y, kv.y}; *(LAS f32x4*)(fa + p + 2) = (f32x4){uv.z, kv.z, uv.w, kv.w}; }
            if (c + G < DHY) { const float* up1 = uT + (size_t)(c + G) * L; const float* kp1 = KT + (size_t)(c + G) * NFFT;
#pragma unroll
                for (int r = 0; r < 8; ++r) pkv[r] = __builtin_nontemporal_load((const f32x4*)(kp1 + 4 * (tid + 512 * r)));
#pragma unroll
                for (int r = 0; r < 4; ++r) puv[r] = *(const f32x4*)(up1 + 4 * (tid + 512 * r)); }
            __syncthreads();
            pass16<10, true>(fa, tid); __syncthreads();
            pass16<6, true>(fa, tid); __syncthreads();
            pass16<2, true>(fa, tid); __syncthreads();
            pass4<-1>(fa, tid); __syncthreads();
            {   const float sc = 0.25f / (float)NFFT;
#pragma unroll
                for (int r = 0; r < 16; ++r) { const int idx = tid + 512 * r;
                    const int f = (idx >> 9) + 16 * ((idx >> 5) & 15) + 256 * ((idx >> 1) & 15) + 4096 * (idx & 1);
                    const int fp = (NFFT - f) & (NFFT - 1);
                    const int p = PADI(fpos(f)), pp = PADI(fpos(fp));
                    const cf A = fa[p], Bc = fa[pp];
                    const float dx = (A.x * A.x - A.y * A.y) - (Bc.x * Bc.x - Bc.y * Bc.y), dy = 2.f * A.x * A.y + 2.f * Bc.x * Bc.y;
                    const cf Y = {dy * sc, -dx * sc};
                    if (hold) Yr[r] = Y;
                    else if (second) { const cf Y1 = Yr[r]; fa[p] = (cf){Y1.x - Y.y, Y1.y + Y.x}; fa[pp] = (cf){Y1.x + Y.y, Y.x - Y1.y}; }
                    else { fa[p] = Y; fa[pp] = (cf){Y.x, -Y.y}; } }
                if (tid == 0) { const int p = PADI(2); const cf A = fa[p]; const float yh = A.x * A.y * (1.0f / (float)NFFT);
                    if (hold) Yh = yh; else if (second) fa[p] = (cf){Yh, yh}; else fa[p] = (cf){yh, 0.f}; }
            }
            if (hold) continue;
            __syncthreads();
            pass4<1>(fa, tid); __syncthreads();
            pass16<2, false>(fa, tid); __syncthreads();
            pass16<6, false>(fa, tid); __syncthreads();
            const int c1 = second ? c - G : c;
            f32x4 ou0[2][2], ou1[2][2]; u32x4 ox0[2][2];
#pragma unroll
            for (int q = 0; q < 2; ++q) { const int cc = q ? c : c1;
#pragma unroll
                for (int r = 0; r < 2; ++r) { const int t0 = 8 * (tid + 512 * r); const float* upq = uT + (size_t)cc * L;
                    ou0[q][r] = *(const f32x4*)(upq + t0); ou1[q][r] = *(const f32x4*)(upq + t0 + 4); ox0[q][r] = *(const u32x4*)(x0T + (size_t)cc * L + t0); } }
            pass16<10, false>(fa, tid); __syncthreads();
#pragma unroll
            for (int q = 0; q < 2; ++q) { if (q == 1 && !second) break;
                const int cc = q ? c : c1; const float bias = hyb[cc];
#pragma unroll
                for (int r = 0; r < 2; ++r) { const int t0 = 8 * (tid + 512 * r); const int p = PADI(t0);
                    float y[8];
#pragma unroll
                    for (int i = 0; i < 4; ++i) { const f32x4 qv = *(LAS f32x4*)(fa + p + 2 * i); y[2 * i] = q ? qv.y : qv.x; y[2 * i + 1] = q ? qv.w : qv.z; }
                    float x0v[8]; unpack8(ox0[q][r], x0v);
                    const float uu[8] = {ou0[q][r].x, ou0[q][r].y, ou0[q][r].z, ou0[q][r].w, ou1[q][r].x, ou1[q][r].y, ou1[q][r].z, ou1[q][r].w};
                    float o[8];
#pragma unroll
                    for (int i = 0; i < 8; ++i) o[i] = x0v[i] * (y[i] + bias * uu[i]);
                    *(u32x4*)(yaT + (size_t)cc * L + t0) = pack8(o); } }
        }
    }
    SEAM(3);

    if (IN(4)) {
        bf16_t* ycat = abuf;
        for (int item = bid; item < 128 * 8; item += G) {
            const int tb = item >> 3, cb = item & 7, t0 = tb * 64 + wave * 8, c2 = cb * 128 + 2 * lane;
            const u32x4 ra = *(const u32x4*)(yaT + (size_t)c2 * L + t0), rb = *(const u32x4*)(yaT + (size_t)(c2 + 1) * L + t0);
            const unsigned wa[4] = {ra.x, ra.y, ra.z, ra.w}, wb[4] = {rb.x, rb.y, rb.z, rb.w};
#pragma unroll
            for (int i = 0; i < 4; ++i) {
                *(unsigned*)(ycat + (size_t)(t0 + 2 * i) * D + c2) = (wa[i] & 0xffffu) | (wb[i] << 16);
                *(unsigned*)(ycat + (size_t)(t0 + 2 * i + 1) * D + c2) = (wa[i] >> 16) | (wb[i] & 0xffff0000u); }
        }
    }
    SEAM(4);

    if (IN(5)) {
        pg8::Gemm g{abuf, Wt_out, L, D, D, D, D, 0}; pg8::StaticOrder S; S.init(L, D, G, bid);
        pg8::EpiRowScaleBf16<false> E{nullptr, D, nullptr};
        f32x4 acc[2][2][4][2]; pg8::Unit cu{0, 0}; const bool has = pg8::gemm_phase<pg8::EpiRowScaleBf16<false>, false, true>(lds, g, S, E, acc, cu);
        const FusedArgs F{x, xres, abuf, rA, norm_g + 1 * D, nullptr, nullptr, sspart, sspart2};
        fused_res_epilogue<0>(acc, has, cu, F, (LAS float*)lds, xbar, tid);
    }
    SEAM(5);
    if (IN(7)) {
        pg8::Gemm g{abuf, Wt_1, L, DFF, D, D, D, 0}; pg8::StaticOrder S; S.init(L, DFF, G, bid);
        pg8::EpiRowScaleBf16<true> E{hmid, DFF, rA};
        f32x4 acc[2][2][4][2]; pg8::Unit cu; pg8::gemm_phase<pg8::EpiRowScaleBf16<true>, true>(lds, g, S, E, acc, cu);
    }
    SEAM(7);
    if (IN(8)) {
        pg8::Gemm g{hmid, Wt_2, L, D, DFF, DFF, DFF, 0}; pg8::StaticOrder S; S.init(L, D, G, bid);
        pg8::EpiRowScaleBf16<false> E{nullptr, D, nullptr};
        f32x4 acc[2][2][4][2]; pg8::Unit cu{0, 0}; const bool has = pg8::gemm_phase<pg8::EpiRowScaleBf16<false>, false, true>(lds, g, S, E, acc, cu);
        const FusedArgs F{xres, xres, hb, nullptr, norm_g + 3 * D, norm_g + 4 * D, nullptr, sspart, sspart2};
        fused_res_epilogue<1>(acc, has, cu, F, (LAS float*)lds, xbar, tid);
    }
    SEAM(8);
    if (IN(10)) {
        const int chunk = tid & 255, c8 = chunk * 8, rsel = (tid >> 6) & 3;
        for (int it = bid * 2 + (tid >> 8); it < 1024; it += 2 * G) {
            const int t0 = it * 8;
            auto body = [&](auto RC) {
                constexpr int R = decltype(RC)::value;
                u32x4 rows[8 + 2 * R]; const u32x4 zero = {0u, 0u, 0u, 0u};
#pragma unroll
                for (int i = 0; i < 8 + 2 * R; ++i) { const int tr = t0 - R + i; rows[i] = (tr >= 0 && tr < L) ? *(const u32x4*)(hb + (size_t)tr * D + c8) : zero; }
                float S[8];
#pragma unroll
                for (int i = 0; i < 8; ++i) S[i] = 0.f;
#pragma unroll
                for (int j = 0; j < 2 * R + 1; ++j) { float v[8]; unpack8(rows[j], v);
#pragma unroll
                    for (int i = 0; i < 8; ++i) S[i] += v[i]; }
#pragma unroll
                for (int k = 0; k < 8; ++k) {
                    const int t = t0 + k, lo2 = max(t - R, 0), hi2 = min(t + R + 1, L); const float inv = 1.0f / (float)(hi2 - lo2);
                    float hv[8], o[8]; unpack8(rows[k + R], hv);
#pragma unroll
                    for (int i = 0; i < 8; ++i) o[i] = S[i] * inv - hv[i];
                    *(u32x4*)(abuf + (size_t)t * D + c8) = pack8(o);
                    if (k < 7) { float va[8], vs[8]; unpack8(rows[k + 2 * R + 1], va); unpack8(rows[k], vs);
#pragma unroll
                        for (int i = 0; i < 8; ++i) S[i] += va[i] - vs[i]; }
                }
            };
            if (rsel == 0) body(std::integral_constant<int, 1>{}); else if (rsel == 1) body(std::integral_constant<int, 2>{});
            else if (rsel == 2) body(std::integral_constant<int, 4>{}); else body(std::integral_constant<int, 8>{});
        }
    }
    SEAM(10);
    if (IN(11)) {
        pg8::Gemm g{abuf, Wt_pool, L, D, 512, D, 512, 512}; pg8::StaticOrder S; S.init(L, D, G, bid);
        pg8::EpiRowScaleBf16<false> E{nullptr, D, nullptr};
        f32x4 acc[2][2][4][2]; pg8::Unit cu{0, 0}; const bool has = pg8::gemm_phase<pg8::EpiRowScaleBf16<false>, false, true>(lds, g, S, E, acc, cu);
        const FusedArgs F{xres, xres, abuf, rA, norm_g + 5 * D, nullptr, a.in[16], sspart, sspart2};
        fused_res_epilogue<0>(acc, has, cu, F, (LAS float*)lds, xbar, tid);
    }
    SEAM(11);
    if (IN(13)) {
        pg8::Gemm g{abuf, Wt_1 + (size_t)DFF * D, L, DFF, D, D, D, 0}; pg8::StaticOrder S; S.init(L, DFF, G, bid);
        pg8::EpiRowScaleBf16<true> E{hmid, DFF, rA};
        f32x4 acc[2][2][4][2]; pg8::Unit cu; pg8::gemm_phase<pg8::EpiRowScaleBf16<true>, true>(lds, g, S, E, acc, cu);
    }
    SEAM(13);
    if (IN(14)) {
        pg8::Gemm g{hmid, Wt_2 + (size_t)D * DFF, L, D, DFF, DFF, DFF, 0}; pg8::StaticOrder S; S.init(L, D, G, bid);
        pg8::EpiRowScaleBf16<false> E{nullptr, D, nullptr};
        f32x4 acc[2][2][4][2]; pg8::Unit cu{0, 0}; const bool has = pg8::gemm_phase<pg8::EpiRowScaleBf16<false>, false, true>(lds, g, S, E, acc, cu);
        const FusedArgs F{xres, xres, nullptr, nullptr, norm_g + 7 * D, nullptr, nullptr, sspart, sspart2};
        fused_res_epilogue<2>(acc, has, cu, F, (LAS float*)lds, xbar, tid);
    }
}


extern "C" void kernel_launch(void* const* d_in, const int* in_sizes, int n_in, void* d_out, int out_size, void* d_ws, size_t ws_size, hipStream_t stream) {
    static int grid = 0;
    if (grid == 0) {
        if (n_in != 19 || out_size != L * D || ws_size < WS_END) { fprintf(stderr, "kernel_launch: unexpected shapes (n_in %d out %d ws %zu)\n", n_in, out_size, ws_size); grid = -1; return; }
        int dev = 0, cus = 0, per_cu = 0;
        hipGetDevice(&dev); hipDeviceGetAttribute(&cus, hipDeviceAttributeMultiprocessorCount, dev);
        if (hipFuncSetAttribute((const void*)fwd_kernel, hipFuncAttributeMaxDynamicSharedMemorySize, LDS_BYTES) != hipSuccess) { fprintf(stderr, "kernel_launch: hipFuncSetAttribute failed\n"); grid = -1; return; }
        if (hipOccupancyMaxActiveBlocksPerMultiprocessor(&per_cu, (const void*)fwd_kernel, 512, LDS_BYTES) != hipSuccess || per_cu < 1) { fprintf(stderr, "kernel_launch: occupancy query says %d\n", per_cu); per_cu = 1; }
        (void)hipGetLastError();
        grid = cus * per_cu;
        if (grid < 256) { fprintf(stderr, "kernel_launch: the fused GEMM epilogues need >= 256 co-resident workgroups, got %d\n", grid); grid = -1; return; }
    }
    if (grid < 0) return;
    if (hipMemsetAsync((char*)d_ws + WS_CTL, 0, CTL_BYTES, stream) != hipSuccess) { fprintf(stderr, "kernel_launch: memset failed\n"); return; }
    Args a{};
    for (int i = 0; i < 19; ++i) a.in[i] = (const float*)d_in[i];
    a.out = (float*)d_out; a.ws = (unsigned char*)d_ws;
    a.ph_lo = 0; a.ph_hi = NPHASE;
    void* args[] = {&a};
    hipError_t e = hipLaunchCooperativeKernel((const void*)fwd_kernel, dim3(grid), dim3(512), args, LDS_BYTES, stream);
    if (e != hipSuccess) fprintf(stderr, "cooperative launch failed: %s (grid %d)\n", hipGetErrorString(e), grid);
}
```

```cpp
#include <hip/hip_runtime.h>
#include <hip/hip_cooperative_groups.h>
#include <cstdio>
#include <cstdint>
#include <type_traits>
namespace cg = cooperative_groups;


#define LAS __attribute__((address_space(3)))
typedef unsigned short bf16_t;
typedef short bf16x8 __attribute__((ext_vector_type(8)));
typedef float f32x4 __attribute__((ext_vector_type(4)));
typedef float f32x2 __attribute__((ext_vector_type(2)));
typedef unsigned u32x4 __attribute__((ext_vector_type(4)));
typedef unsigned u32x2 __attribute__((ext_vector_type(2)));

constexpr int L = 8192, D = 2048, DIN = 6144, DHY = 1024, DFF = 8192, NFFT = 16384;
constexpr size_t MiB = 1024ull * 1024ull;
constexpr size_t WS_WIN = 0, WS_WOUT = 24 * MiB, WS_W1 = 32 * MiB, WS_W2 = 96 * MiB, WS_WPOOL = 160 * MiB, WS_SMALL = 162 * MiB,
                 WS_ABUF = 166 * MiB, WS_ABUF2 = 198 * MiB, WS_M = 230 * MiB, WS_H = 294 * MiB, WS_END = 422 * MiB;
constexpr int FFT_LDS_BYTES = (NFFT / 64) * 68 * 8;
constexpr int LDS_BYTES = FFT_LDS_BYTES + 64;
constexpr size_t WS_CTL = WS_SMALL + 64 * 1024, CTL_BYTES = 16 * 1024;
constexpr int NPHASE = 16;

__device__ __forceinline__ unsigned pk2(float lo, float hi) { unsigned r; asm volatile("v_cvt_pk_bf16_f32 %0, %1, %2" : "=v"(r) : "v"(lo), "v"(hi)); return r; }
__device__ __forceinline__ float bf_lo(unsigned w) { return __uint_as_float(w << 16); }
__device__ __forceinline__ float bf_hi(unsigned w) { return __uint_as_float(w & 0xffff0000u); }
__device__ __forceinline__ void unpack8(u32x4 w, float* f) { f[0] = bf_lo(w.x); f[1] = bf_hi(w.x); f[2] = bf_lo(w.y); f[3] = bf_hi(w.y); f[4] = bf_lo(w.z); f[5] = bf_hi(w.z); f[6] = bf_lo(w.w); f[7] = bf_hi(w.w); }
__device__ __forceinline__ u32x4 pack8(const float* f) { u32x4 o; o.x = pk2(f[0], f[1]); o.y = pk2(f[2], f[3]); o.z = pk2(f[4], f[5]); o.w = pk2(f[6], f[7]); return o; }
__device__ __forceinline__ float wave_sum(float v) {
#pragma unroll
    for (int o = 1; o < 64; o <<= 1) v += __shfl_xor(v, o);
    return v;
}
__device__ __forceinline__ float sin_rev(float r) { return __builtin_amdgcn_sinf(r); }
__device__ __forceinline__ float cos_rev(float r) { return __builtin_amdgcn_cosf(r); }
#define LDS_WAIT() asm volatile("s_waitcnt lgkmcnt(0)" ::: "memory")

namespace pg8 {
constexpr int BM = 256, BK = 64, HALF = 128, HTB = HALF * BK * 2, STAGE_BYTES = 8 * HTB, NXCD = 8, WGM = 3;
__host__ __device__ __forceinline__ int lds_byte(int r, int c) { const int st = (r >> 4) * 2 + (c >> 5), rr = r & 15, cc = c & 31, ob = rr * 64 + cc * 2; return st * 1024 + (ob ^ (((ob >> 9) & 1) << 5)); }
__host__ __device__ __forceinline__ void stage_rc(int b, int& R, int& C) { const int st = b / 1024, sb = b % 1024, swz = sb ^ (((sb >> 9) & 1) << 5); R = (st >> 1) * 16 + swz / 64; C = (st & 1) * 32 + (swz % 64) / 2; }
__host__ __device__ __forceinline__ int perm32(int rho) { const int n = rho >> 4, i = rho & 15; return 8 * (i >> 2) + 4 * n + (i & 3); }
struct Unit { int pm, pn; };
struct Gemm { const bf16_t* A; const bf16_t* Bt; int M, N, K, lda, ldb, apn_mul; };
struct StaticOrder {
    int nM, nN, nwg, G, c;
    __host__ __device__ void init(int M, int N, int G_, int c_) { nM = M / BM; nN = N / BM; nwg = nM * nN; G = G_; c = c_; }
    __host__ __device__ bool next(int i, Unit& u) const {
        const long Lx = (long)i * G + c; if (Lx >= nwg) return false;
        int wgid = (int)Lx; { const int q = nwg / NXCD, r = nwg % NXCD, xcd = wgid % NXCD, off = wgid / NXCD; wgid = (xcd < r ? xcd * (q + 1) : r * (q + 1) + (xcd - r) * q) + off; }
        const int nig = WGM * nN, gid = wgid / nig, fm = gid * WGM, gsz = (nM - fm) < WGM ? (nM - fm) : WGM;
        u.pm = fm + ((wgid % nig) % gsz); u.pn = (wgid % nig) / gsz; return true;
    }
};

template <bool SQRELU> struct EpiRowScaleBf16 {
    static constexpr bool PERM = true;
    bf16_t* O; int ldc; const float* rs;
    __device__ __forceinline__ void operator()(const f32x4 (&acc)[2][2][4][2], const Unit& u, int wr, int wc, int fr, int fq) const {
        const int row0 = u.pm * BM + wr * 64 + fr, col0 = u.pn * BM + wc * 32 + 8 * fq;
#pragma unroll
        for (int ai = 0; ai < 2; ++ai)
#pragma unroll
            for (int m = 0; m < 4; ++m) { const int row = row0 + ai * HALF + m * 16; const float r = rs[row]; bf16_t* rowp = O + (size_t)row * ldc + col0;
#pragma unroll
                for (int bj = 0; bj < 2; ++bj) { f32x4 v0 = acc[ai][bj][m][0] * r, v1 = acc[ai][bj][m][1] * r;
                    if (SQRELU) {
#pragma unroll
                        for (int j = 0; j < 4; ++j) { float a = fmaxf(v0[j], 0.f), b = fmaxf(v1[j], 0.f); v0[j] = a * a; v1[j] = b * b; } }
                    u32x4 w; w.x = pk2(v0[0], v0[1]); w.y = pk2(v0[2], v0[3]); w.z = pk2(v1[0], v1[1]); w.w = pk2(v1[2], v1[3]);
                    *(u32x4*)(rowp + bj * HALF) = w; } }
    }
};
struct EpiF32SS {
    static constexpr bool PERM = false;
    float* C; int ldc; const float* cs; float* sspart;
    __device__ __forceinline__ void operator()(const f32x4 (&acc)[2][2][4][2], const Unit& u, int wr, int wc, int fr, int fq) const {
        const int row0 = u.pm * BM + wr * 64 + fr, col0 = u.pn * BM + wc * 32 + 4 * fq;
        f32x4 sv[2][2];
#pragma unroll
        for (int bj = 0; bj < 2; ++bj)
#pragma unroll
            for (int n = 0; n < 2; ++n) sv[bj][n] = cs ? *(const f32x4*)(cs + col0 + bj * HALF + n * 16) : (f32x4){1.f, 1.f, 1.f, 1.f};
#pragma unroll
        for (int ai = 0; ai < 2; ++ai)
#pragma unroll
            for (int m = 0; m < 4; ++m) { const int row = row0 + ai * HALF + m * 16; float* rowp = C + (size_t)row * ldc + col0; float s = 0.f;
#pragma unroll
                for (int bj = 0; bj < 2; ++bj)
#pragma unroll
                    for (int n = 0; n < 2; ++n) { const f32x4 v = acc[ai][bj][m][n] * sv[bj][n]; *(f32x4*)(rowp + bj * HALF + n * 16) = v; s += (v[0] * v[0] + v[1] * v[1]) + (v[2] * v[2] + v[3] * v[3]); }
                s += __shfl_xor(s, 16); s += __shfl_xor(s, 32);
                if (fq == 0) sspart[(size_t)row * 32 + u.pn * 4 + wc] = s; }
    }
};

template <class Epi, bool ALIGN_EPI = false, bool FUSED = false>
__device__ __forceinline__ bool gemm_phase(LAS unsigned char* lds, const Gemm g, const StaticOrder& S, const Epi& E, f32x4 (&acc)[2][2][4][2], Unit& cur) {
    const int tid = threadIdx.x, wid = __builtin_amdgcn_readfirstlane(tid >> 6), lane = tid & 63, wr = wid >> 2, wc = wid & 3, fr = lane & 15, fq = lane >> 4;
    const int K = g.K, nt = K / BK;
    unsigned voffA[2], voffB[2];
#pragma unroll
    for (int i = 0; i < 2; ++i) { int R, C; stage_rc(tid * 16 + i * 8192, R, C); const int Rb = Epi::PERM ? ((R & ~31) + perm32(R & 31)) : R;
        voffA[i] = (unsigned)(R * g.lda + C) * 2u; voffB[i] = (unsigned)(Rb * g.ldb + C) * 2u; }
    const size_t kstep = (size_t)(BK * 2);
    const size_t hstepA = (size_t)HALF * g.lda * 2, hstepB = (size_t)HALF * g.ldb * 2;
    const size_t tstepA = 2 * hstepA, tstepB = 2 * hstepB;
    const unsigned ldsw = (unsigned)wid * 1024u;
    const int aoff = lds_byte(wr * 64 + fr, fq * 8), boff = lds_byte(wc * 32 + fr, fq * 8);
#define PG8_SA(b, h) (((b) * 2 + (h)) * HTB)
#define PG8_SB(b, h) ((4 + (b) * 2 + (h)) * HTB)
#define PG8_STAGE(bufoff, gbase, voff) do { _Pragma("unroll") for (int _i = 0; _i < 2; ++_i) \
        __builtin_amdgcn_global_load_lds((const unsigned*)((const char*)(gbase) + (voff)[_i]), (LAS unsigned*)(lds + (bufoff) + ldsw + _i * 8192), 16, 0, 0); } while (0)
#define PG8_LDA(dst, b, h) do { _Pragma("unroll") for (int m = 0; m < 4; ++m) _Pragma("unroll") for (int k = 0; k < 2; ++k) dst[m][k] = *(const LAS bf16x8*)(lds + PG8_SA(b, h) + aoff + m * 2048 + k * 1024); } while (0)
#define PG8_LDB(dst, b, h) do { _Pragma("unroll") for (int n = 0; n < 2; ++n) _Pragma("unroll") for (int k = 0; k < 2; ++k) dst[n][k] = *(const LAS bf16x8*)(lds + PG8_SB(b, h) + boff + n * 2048 + k * 1024); } while (0)
#define PG8_MMA(ai, bj, At, Bt) do { __builtin_amdgcn_s_setprio(1); _Pragma("unroll") for (int m = 0; m < 4; ++m) _Pragma("unroll") for (int n = 0; n < 2; ++n) _Pragma("unroll") for (int k = 0; k < 2; ++k) \
        acc[ai][bj][m][n] = __builtin_amdgcn_mfma_f32_16x16x32_bf16(Bt[n][k], At[m][k], acc[ai][bj][m][n], 0, 0, 0); __builtin_amdgcn_s_setprio(0); } while (0)
#define PG8_WAIT_V(n) asm volatile("s_waitcnt vmcnt(" #n ")" ::: "memory")
#define PG8_WAIT_L(n) asm volatile("s_waitcnt lgkmcnt(" #n ")" ::: "memory")
#define PG8_BAR __builtin_amdgcn_s_barrier()
#define PG8_SCHED __builtin_amdgcn_sched_barrier(0)
    Unit nxt; int ui = 0;
    if (!S.next(0, cur)) return false;
#pragma unroll
    for (int a = 0; a < 2; ++a)
#pragma unroll
        for (int b = 0; b < 2; ++b)
#pragma unroll
            for (int m = 0; m < 4; ++m)
#pragma unroll
                for (int n = 0; n < 2; ++n) acc[a][b][m][n] = (f32x4){0.f, 0.f, 0.f, 0.f};
    bf16x8 At[4][2], B0[2][2], B1[2][2];
    const char* cA = (const char*)g.A + (size_t)cur.pm * tstepA + (size_t)((cur.pn >> 1) * g.apn_mul) * 2; const char* cB = (const char*)g.Bt + (size_t)cur.pn * tstepB;
    PG8_STAGE(PG8_SB(0, 0), cB, voffB); PG8_STAGE(PG8_SB(0, 1), cB + hstepB, voffB); PG8_STAGE(PG8_SA(0, 0), cA, voffA); PG8_STAGE(PG8_SA(0, 1), cA + hstepA, voffA);
    if (wr == 1) PG8_BAR;
    PG8_WAIT_V(2); PG8_BAR;
    PG8_STAGE(PG8_SB(1, 0), cB + kstep, voffB); PG8_STAGE(PG8_SA(1, 0), cA + kstep, voffA); PG8_STAGE(PG8_SB(1, 1), cB + hstepB + kstep, voffB);
    PG8_WAIT_V(6); PG8_BAR;
    for (;;) {
        const bool has_next = S.next(ui + 1, nxt);
        const char* nA = has_next ? (const char*)g.A + (size_t)nxt.pm * tstepA + (size_t)((nxt.pn >> 1) * g.apn_mul) * 2 : cA; const char* nB = has_next ? (const char*)g.Bt + (size_t)nxt.pn * tstepB : cB;
        for (int t = 0; t < nt; t += 2) {
            const bool last = (t == nt - 2);
            const char* a1 = cA + (size_t)(t + 1) * kstep;
            const char* a2 = last ? nA : cA + (size_t)(t + 2) * kstep; const char* b2 = last ? nB : cB + (size_t)(t + 2) * kstep;
            const char* a3 = a2 + kstep; const char* b3 = b2 + kstep;
            PG8_LDB(B0, 0, 0); PG8_LDB(B1, 0, 1); PG8_SCHED; PG8_LDA(At, 0, 0); PG8_STAGE(PG8_SA(1, 1), a1 + hstepA, voffA);
            PG8_WAIT_V(8); PG8_WAIT_L(0); PG8_BAR; PG8_MMA(0, 0, At, B0); PG8_MMA(0, 1, At, B1); PG8_BAR; PG8_SCHED;
            PG8_LDA(At, 0, 1); PG8_STAGE(PG8_SB(0, 0), b2, voffB); PG8_STAGE(PG8_SB(0, 1), b2 + hstepB, voffB); PG8_STAGE(PG8_SA(0, 0), a2, voffA);
            PG8_WAIT_V(8); PG8_WAIT_L(0); PG8_BAR; PG8_MMA(1, 0, At, B0); PG8_MMA(1, 1, At, B1); PG8_BAR; PG8_SCHED;
            PG8_LDB(B0, 1, 0); PG8_LDB(B1, 1, 1); PG8_SCHED; PG8_LDA(At, 1, 0); PG8_STAGE(PG8_SA(0, 1), a2 + hstepA, voffA);
            PG8_WAIT_V(8); PG8_WAIT_L(0); PG8_BAR; PG8_MMA(0, 0, At, B0); PG8_MMA(0, 1, At, B1); PG8_BAR; PG8_SCHED;
            PG8_LDA(At, 1, 1); PG8_STAGE(PG8_SB(1, 0), b3, voffB); PG8_STAGE(PG8_SB(1, 1), b3 + hstepB, voffB); PG8_STAGE(PG8_SA(1, 0), a3, voffA);
            PG8_WAIT_V(8); PG8_WAIT_L(0); PG8_BAR; PG8_MMA(1, 0, At, B0); PG8_MMA(1, 1, At, B1); PG8_BAR; PG8_SCHED;
        }
        if constexpr (ALIGN_EPI) { if (wr == 0) PG8_BAR; }
        if constexpr (!FUSED) E(acc, cur, wr, wc, fr, fq);
        if (!has_next) break;
#pragma unroll
        for (int a = 0; a < 2; ++a)
#pragma unroll
            for (int b = 0; b < 2; ++b)
#pragma unroll
                for (int m = 0; m < 4; ++m)
#pragma unroll
                    for (int n = 0; n < 2; ++n) acc[a][b][m][n] = (f32x4){0.f, 0.f, 0.f, 0.f};
        cur = nxt; cA = nA; cB = nB; ++ui;
        if constexpr (ALIGN_EPI) { if (wr == 1) PG8_BAR; }
    }
    PG8_WAIT_V(0);
    if constexpr (!ALIGN_EPI) { if (wr == 0) PG8_BAR; }
    PG8_BAR;
    return true;
#undef PG8_SA
#undef PG8_SB
#undef PG8_STAGE
#undef PG8_LDA
#undef PG8_LDB
#undef PG8_MMA
#undef PG8_WAIT_V
#undef PG8_WAIT_L
#undef PG8_BAR
#undef PG8_SCHED
}
}

__device__ __forceinline__ void transpose_item(const float* __restrict__ W, int N, bf16_t* WT, int ldt, int row_off, const float* __restrict__ gs, LAS float* scr, int item, int lane, bool late = false) {
    const int nblk = N / 64, kb = item / nblk, nb = item % nblk, k0 = 64 * kb, n0 = 64 * nb;
    const int ks = lane >> 4, n4 = lane & 15;
    f32x4 v[16];
#pragma unroll
    for (int i = 0; i < 16; ++i) v[i] = __builtin_nontemporal_load((const f32x4*)(W + (size_t)(k0 + 4 * i + ks) * N + n0 + 4 * n4));
    if (gs) {
#pragma unroll
        for (int i = 0; i < 16; ++i) v[i] = v[i] * gs[k0 + 4 * i + ks];
    }
#pragma unroll
    for (int i = 0; i < 16; ++i) { const int k = 4 * i + ks; scr[(4 * n4 + 0) * 65 + k] = v[i].x; scr[(4 * n4 + 1) * 65 + k] = v[i].y; scr[(4 * n4 + 2) * 65 + k] = v[i].z; scr[(4 * n4 + 3) * 65 + k] = v[i].w; }
    LDS_WAIT();
    const int c = lane & 7;
#pragma unroll
    for (int j = 0; j < 8; ++j) { const int n = (lane >> 3) + 8 * j; const LAS float* sp = scr + n * 65 + 8 * c;
        u32x4 o; o.x = pk2(sp[0], sp[1]); o.y = pk2(sp[2], sp[3]); o.z = pk2(sp[4], sp[5]); o.w = pk2(sp[6], sp[7]);
        if (late) __builtin_nontemporal_store(o, (u32x4*)(WT + (size_t)(row_off + n0 + n) * ldt + k0 + 8 * c)); else *(u32x4*)(WT + (size_t)(row_off + n0 + n) * ldt + k0 + 8 * c) = o; }
    LDS_WAIT();
}

typedef f32x2 cf;
__device__ __forceinline__ int PADI(int i) { return i + ((i >> 6) << 2); }
__device__ __forceinline__ cf cmul(cf a, cf b) { return (cf){a.x * b.x - a.y * b.y, a.x * b.y + a.y * b.x}; }
template <int SIGN> __device__ __forceinline__ void dft4(cf& a, cf& b, cf& c, cf& d) {
    const cf s0 = a + c, s1 = a - c, s2 = b + d, s3 = b - d;
    a = s0 + s2; c = s0 - s2;
    if (SIGN < 0) { b = (cf){s1.x + s3.y, s1.y - s3.x}; d = (cf){s1.x - s3.y, s1.y + s3.x}; }
    else          { b = (cf){s1.x - s3.y, s1.y + s3.x}; d = (cf){s1.x + s3.y, s1.y - s3.x}; }
}
template <int SIGN> __device__ __forceinline__ cf mulw(cf x, float c, float s) { return cmul(x, (cf){c, SIGN * s}); }
template <int SIGN> __device__ __forceinline__ void dft16(cf (&x)[16]) {
#pragma unroll
    for (int n2 = 0; n2 < 4; ++n2) dft4<SIGN>(x[n2], x[4 + n2], x[8 + n2], x[12 + n2]);
    constexpr float C1 = 0.92387953251f, S1 = 0.38268343236f, C2 = 0.70710678118f;
    x[5] = mulw<SIGN>(x[5], C1, S1); x[6] = mulw<SIGN>(x[6], C2, C2); x[7] = mulw<SIGN>(x[7], S1, C1);
    x[9] = mulw<SIGN>(x[9], C2, C2); x[10] = (SIGN < 0) ? (cf){x[10].y, -x[10].x} : (cf){-x[10].y, x[10].x}; x[11] = mulw<SIGN>(x[11], -C2, C2);
    x[13] = mulw<SIGN>(x[13], S1, C1); x[14] = mulw<SIGN>(x[14], -C2, C2); x[15] = mulw<SIGN>(x[15], -C1, -S1);
#pragma unroll
    for (int k1 = 0; k1 < 4; ++k1) dft4<SIGN>(x[4 * k1], x[4 * k1 + 1], x[4 * k1 + 2], x[4 * k1 + 3]);
}
template <int LOG2S, bool FWD> __device__ __forceinline__ void pass16(LAS cf* a, int tid) {
    constexpr int S = 1 << LOG2S, NC = 16 * S, PS = S + ((S >> 6) << 2);
#pragma unroll 1
    for (int r = 0; r < 2; ++r) {
        const int b = tid + 512 * r, j = b & (S - 1), blk = b >> LOG2S, base = blk * NC + j;
        LAS cf* ap = a + PADI(base);
        cf x[16];
#pragma unroll
        for (int k = 0; k < 16; ++k) x[k] = ap[k * PS];
        float jr = (float)j * (1.0f / NC);
        asm volatile("" : "+v"(jr));
        const cf w1 = {cos_rev(jr), FWD ? -sin_rev(jr) : sin_rev(jr)};
        cf w = w1;
        if (!FWD) {
#pragma unroll
            for (int k = 1; k < 16; ++k) { x[k] = cmul(x[k], w); if (k < 15) w = cmul(w, w1); }
            dft16<1>(x);
        } else {
            dft16<-1>(x);
#pragma unroll
            for (int k = 1; k < 16; ++k) { const int sl = 4 * (k & 3) + (k >> 2); x[sl] = cmul(x[sl], w); if (k < 15) w = cmul(w, w1); }
        }
#pragma unroll
        for (int k = 0; k < 16; ++k) ap[k * PS] = x[4 * (k & 3) + (k >> 2)];
    }
}
template <int SIGN> __device__ __forceinline__ void pass4(LAS cf* a, int tid) {
#pragma unroll 2
    for (int r = 0; r < 8; ++r) {
        const int p = PADI(4 * (tid + 512 * r));
        f32x4 u0 = *(LAS f32x4*)(a + p), u1 = *(LAS f32x4*)(a + p + 2);
        cf x0 = {u0.x, u0.y}, x1 = {u0.z, u0.w}, x2 = {u1.x, u1.y}, x3 = {u1.z, u1.w};
        dft4<SIGN>(x0, x1, x2, x3);
        *(LAS f32x4*)(a + p) = (f32x4){x0.x, x0.y, x1.x, x1.y}; *(LAS f32x4*)(a + p + 2) = (f32x4){x2.x, x2.y, x3.x, x3.y};
    }
}
__device__ __forceinline__ int fpos(int f) { return 1024 * (f & 15) + 64 * ((f >> 4) & 15) + 4 * ((f >> 8) & 15) + (f >> 12); }

struct RowBuf { f32x4 x[8], m[8]; float sp; };
__device__ __forceinline__ void row_load(RowBuf& b, const float* xin, const float* m, const float* sspart, int row, int lane) {
    const f32x4* xr = (const f32x4*)(xin + (size_t)row * D) + lane; const f32x4* mr = (const f32x4*)(m + (size_t)row * D) + lane;
    b.sp = (lane < 32) ? sspart[(size_t)row * 32 + lane] : 0.f;
#pragma unroll
    for (int j = 0; j < 8; ++j) { b.x[j] = xr[64 * j]; b.m[j] = mr[64 * j]; }
}
template <int MODE> __device__ __forceinline__ void row_compute(RowBuf& b, const f32x4 (&gv)[8], float* xout, bf16_t* bout, float* rnext, const float* __restrict__ gnext, int row, int lane) {
    const float rm = rsqrtf(wave_sum(b.sp) * (1.0f / D) + 1e-6f);
    float ss = 0.f;
    f32x4* xo = (f32x4*)(xout + (size_t)row * D) + lane;
#pragma unroll
    for (int j = 0; j < 8; ++j) { const f32x4 v = b.x[j] + b.m[j] * rm * gv[j]; b.x[j] = v; ss += (v.x * v.x + v.y * v.y) + (v.z * v.z + v.w * v.w); xo[64 * j] = v; }
    if (MODE != 2) {
        const float r = rsqrtf(wave_sum(ss) * (1.0f / D) + 1e-6f);
        u32x2* bo = (u32x2*)(bout + (size_t)row * D) + lane;
        if (MODE == 0) {
#pragma unroll
            for (int j = 0; j < 8; ++j) bo[64 * j] = (u32x2){pk2(b.x[j].x, b.x[j].y), pk2(b.x[j].z, b.x[j].w)};
            if (lane == 0) rnext[row] = r;
        } else {
            const f32x4* gn = (const f32x4*)gnext + lane;
#pragma unroll
            for (int j = 0; j < 8; ++j) { const f32x4 w = b.x[j] * r * gn[64 * j]; bo[64 * j] = (u32x2){pk2(w.x, w.y), pk2(w.z, w.w)}; }
        }
    }
}
template <int MODE> __device__ __forceinline__ void row_phase(const float* xin, const float* m, const float* sspart, const float* __restrict__ g, float* xout, bf16_t* bout, float* rnext, const float* __restrict__ gnext, int gw, int ngw, int lane) {
    if (gw >= L) return;
    f32x4 gv[8];
#pragma unroll
    for (int j = 0; j < 8; ++j) gv[j] = ((const f32x4*)g + lane)[64 * j];
    RowBuf A, B;
    row_load(A, xin, m, sspart, gw, lane);
    for (int row = gw; row < L; row += 2 * ngw) {
        const bool hasB = (row + ngw < L);
        if (hasB) row_load(B, xin, m, sspart, row + ngw, lane);
        row_compute<MODE>(A, gv, xout, bout, rnext, gnext, row, lane);
        if (row + 2 * ngw < L) row_load(A, xin, m, sspart, row + 2 * ngw, lane);
        if (hasB) row_compute<MODE>(B, gv, xout, bout, rnext, gnext, row + ngw, lane);
    }
}

#define XB_TMO      128
#define XB_XCNT(j)  (256  + 64 * (j))
#define XB_XSUB(j)  (1280 + 64 * (j))
#define XB_XGEN(j)  (2304 + 64 * (j))
#define XB_TOP      3328
#define XB_TOPGEN   3392
#define XCD_BAR_WORDS 3456
#define XB_SPIN_CAP (1u << 18)

__device__ __forceinline__ unsigned xb_ld(unsigned* p)              { return __hip_atomic_load(p, __ATOMIC_RELAXED, __HIP_MEMORY_SCOPE_AGENT); }
__device__ __forceinline__ unsigned xb_add(unsigned* p, unsigned v) { return __hip_atomic_fetch_add(p, v, __ATOMIC_RELAXED, __HIP_MEMORY_SCOPE_AGENT); }
__device__ __forceinline__ unsigned xb_xcc_id() { return (unsigned)__builtin_amdgcn_s_getreg((3 << 11) | 20) & 0xFu; }
#define XB_SPIN(cond, bar) do { unsigned _sp = 0; while (cond) { __builtin_amdgcn_s_sleep(1); \
    if ((++_sp & 255u) == 0u) { if (xb_ld(&(bar)[XB_TMO])) break; if (_sp > XB_SPIN_CAP) { atomicAdd(&(bar)[XB_TMO], 1u); break; } } } } while (0)

struct XcdBarrier {
    unsigned* bar; unsigned x;
    volatile LAS unsigned* st;
};

__device__ __forceinline__ XcdBarrier xcd_barrier_post(unsigned* bar, volatile LAS unsigned* st) {
    XcdBarrier b; b.bar = bar; b.x = xb_xcc_id(); b.st = st;
    if (threadIdx.x == 0) (void)xb_add(&bar[XB_XCNT(b.x)], 1u);
    return b;
}
__device__ __forceinline__ void xcd_barrier_complete(unsigned* bar, unsigned x, unsigned& nloc, unsigned& nx) {
    const unsigned G = gridDim.x * gridDim.y * gridDim.z;
    unsigned sum, cnt, mine, sp = 0u;
    for (;;) {
        sum = 0u; cnt = 0u; mine = 0u;
#pragma unroll
        for (unsigned j = 0; j < 16; ++j) { const unsigned c = xb_ld(&bar[XB_XCNT(j)]); sum += c; cnt += (c > 0u) ? 1u : 0u; mine = (j == x) ? c : mine; }
        if (sum == G) break;
        __builtin_amdgcn_s_sleep(1);
        if ((++sp & 255u) == 0u) { if (xb_ld(&bar[XB_TMO])) break; if (sp > XB_SPIN_CAP) { atomicAdd(&bar[XB_TMO], 1u); break; } }
    }
    nloc = mine > 0u ? mine : 1u; nx = cnt > 0u ? cnt : 1u;
}

__device__ __forceinline__ void xcd_barrier(const XcdBarrier& b) {
    asm volatile("s_waitcnt vmcnt(0)" ::: "memory");
    __syncthreads();
    if (threadIdx.x == 0) {
        unsigned* bar = b.bar;
        __builtin_amdgcn_s_waitcnt(0);
        unsigned nloc = b.st[0], nx = b.st[1];
        if (nloc == 0u) { xcd_barrier_complete(bar, b.x, nloc, nx); b.st[0] = nloc; b.st[1] = nx; }
        const unsigned old = xb_add(&bar[XB_XSUB(b.x)], 1u);
        const unsigned gen = old / nloc;
        if (old + 1u == (gen + 1u) * nloc) {
            __builtin_amdgcn_fence(__ATOMIC_RELEASE, "agent");
            asm volatile("s_waitcnt vmcnt(0)" ::: "memory");
            const unsigned og = xb_add(&bar[XB_TOP], 1u);
            const unsigned tg = og / nx;
            if (og + 1u == (tg + 1u) * nx) xb_add(&bar[XB_TOPGEN], 1u);
            else XB_SPIN(xb_ld(&bar[XB_TOPGEN]) == tg, bar);
            __builtin_amdgcn_fence(__ATOMIC_ACQUIRE, "agent");
            xb_add(&bar[XB_XGEN(b.x)], 1u);
            asm volatile("s_waitcnt vmcnt(0)" ::: "memory");
        } else {
            XB_SPIN(xb_ld(&bar[XB_XGEN(b.x)]) == gen, bar);
            __builtin_amdgcn_fence(__ATOMIC_ACQUIRE, "agent");
            asm volatile("s_waitcnt vmcnt(0)" ::: "memory");
        }
    }
    __syncthreads();
}


struct FusedArgs { const float* xin; float* xout; bf16_t* bout; float* rnext; const float* g; const float* gnext; const float* cs; float* ss1; float* ss2; };
__device__ __forceinline__ void panel_rms(const float* ss, int pm, LAS float* S, int tid) {
    const int r = tid >> 1, hf = tid & 1; const f32x4* p = (const f32x4*)(ss + (size_t)(pm * 256 + r) * 32 + hf * 16);
    const f32x4 a0 = p[0], a1 = p[1], a2 = p[2], a3 = p[3];
    float sm = ((a0.x + a0.y) + (a0.z + a0.w)) + ((a1.x + a1.y) + (a1.z + a1.w)) + ((a2.x + a2.y) + (a2.z + a2.w)) + ((a3.x + a3.y) + (a3.z + a3.w));
    sm += __shfl_xor(sm, 1);
    if (hf == 0) S[r] = rsqrtf(sm * (1.0f / D) + 1e-6f);
}
template <int MODE> __device__ __forceinline__ void fused_res_epilogue(f32x4 (&acc)[2][2][4][2], bool has, const pg8::Unit u, const FusedArgs& F, LAS float* S, const XcdBarrier& xbar, int tid) {
    const int lane = tid & 63, wid = __builtin_amdgcn_readfirstlane(tid >> 6), wr = wid >> 2, wc = wid & 3, fr = lane & 15, fq = lane >> 4;
    const int rowl0 = wr * 64 + fr, row0 = u.pm * 256 + rowl0, col0 = u.pn * 256 + wc * 32 + 8 * fq;
    if (has) {
        if (F.cs) {
#pragma unroll
            for (int bj = 0; bj < 2; ++bj)
#pragma unroll
                for (int n = 0; n < 2; ++n) { const f32x4 sv = *(const f32x4*)(F.cs + col0 + bj * 128 + n * 4);
#pragma unroll
                    for (int ai = 0; ai < 2; ++ai)
#pragma unroll
                        for (int m = 0; m < 4; ++m) acc[ai][bj][m][n] = acc[ai][bj][m][n] * sv; } }
#pragma unroll
        for (int ai = 0; ai < 2; ++ai)
#pragma unroll
            for (int m = 0; m < 4; ++m) { float sq = 0.f;
#pragma unroll
                for (int bj = 0; bj < 2; ++bj)
#pragma unroll
                    for (int n = 0; n < 2; ++n) { const f32x4 v = acc[ai][bj][m][n]; sq += (v[0] * v[0] + v[1] * v[1]) + (v[2] * v[2] + v[3] * v[3]); }
                sq += __shfl_xor(sq, 16); sq += __shfl_xor(sq, 32);
                if (fq == 0) F.ss1[(size_t)(row0 + ai * 128 + m * 16) * 32 + u.pn * 4 + wc] = sq; }
    }
    xcd_barrier(xbar);
    if (has) {
        panel_rms(F.ss1, u.pm, S, tid);
        __syncthreads();
        f32x4 gv[2][2];
#pragma unroll
        for (int bj = 0; bj < 2; ++bj)
#pragma unroll
            for (int n = 0; n < 2; ++n) gv[bj][n] = *(const f32x4*)(F.g + col0 + bj * 128 + n * 4);
#pragma unroll
        for (int ai = 0; ai < 2; ++ai) {
            f32x4 xv[4][2][2];
#pragma unroll
            for (int m = 0; m < 4; ++m) { const float* xr = F.xin + (size_t)(row0 + ai * 128 + m * 16) * D + col0;
#pragma unroll
                for (int bj = 0; bj < 2; ++bj)
#pragma unroll
                    for (int n = 0; n < 2; ++n) xv[m][bj][n] = *(const f32x4*)(xr + bj * 128 + n * 4); }
#pragma unroll
            for (int m = 0; m < 4; ++m) { const int rl = rowl0 + ai * 128 + m * 16, row = u.pm * 256 + rl; const float rm = S[rl]; float sq = 0.f;
                float* xo = F.xout + (size_t)row * D + col0;
#pragma unroll
                for (int bj = 0; bj < 2; ++bj)
#pragma unroll
                    for (int n = 0; n < 2; ++n) { const int co = bj * 128 + n * 4;
                        const f32x4 v = xv[m][bj][n] + acc[ai][bj][m][n] * rm * gv[bj][n]; acc[ai][bj][m][n] = v; *(f32x4*)(xo + co) = v;
                        sq += (v[0] * v[0] + v[1] * v[1]) + (v[2] * v[2] + v[3] * v[3]); }
                if (MODE != 2) { sq += __shfl_xor(sq, 16); sq += __shfl_xor(sq, 32);
                    if (fq == 0) F.ss2[(size_t)row * 32 + u.pn * 4 + wc] = sq; } }
        }
    }
    if (MODE == 2) return;
    xcd_barrier(xbar);
    if (has) {
        panel_rms(F.ss2, u.pm, S, tid);
        __syncthreads();
#pragma unroll
        for (int ai = 0; ai < 2; ++ai)
#pragma unroll
            for (int m = 0; m < 4; ++m) { const int rl = rowl0 + ai * 128 + m * 16, row = u.pm * 256 + rl; const float r = S[rl];
                bf16_t* bo = F.bout + (size_t)row * D + col0;
                if (MODE == 0 && u.pn == 0 && wc == 0 && fq == 0) F.rnext[row] = r;
#pragma unroll
                for (int bj = 0; bj < 2; ++bj)
                    { f32x4 v0 = acc[ai][bj][m][0], v1 = acc[ai][bj][m][1];
                        if (MODE == 1) { v0 = v0 * r * *(const f32x4*)(F.gnext + col0 + bj * 128); v1 = v1 * r * *(const f32x4*)(F.gnext + col0 + bj * 128 + 4); }
                        *(u32x4*)(bo + bj * 128) = (u32x4){pk2(v0[0], v0[1]), pk2(v0[2], v0[3]), pk2(v1[0], v1[1]), pk2(v1[2], v1[3])}; } }
    }
}

struct Args { const float* in[19]; float* out; unsigned char* ws; int ph_lo, ph_hi; };

__global__ void __launch_bounds__(512, 2) fwd_kernel(Args a) {
    extern __shared__ __attribute__((aligned(16))) unsigned char smem[];
    LAS unsigned char* lds = (LAS unsigned char*)smem;
    const int tid = threadIdx.x, lane = tid & 63, wave = __builtin_amdgcn_readfirstlane(tid >> 6);
    const int G = gridDim.x, bid = blockIdx.x, gw = bid * 8 + wave, NGW = G * 8;
    unsigned char* ws = a.ws;
    const float* x = a.in[0]; const float* norm_g = a.in[1];
    bf16_t* Wt_in = (bf16_t*)(ws + WS_WIN); bf16_t* Wt_out = (bf16_t*)(ws + WS_WOUT); bf16_t* Wt_1 = (bf16_t*)(ws + WS_W1); bf16_t* Wt_2 = (bf16_t*)(ws + WS_W2); bf16_t* Wt_pool = (bf16_t*)(ws + WS_WPOOL);
    float* rA = (float*)(ws + WS_SMALL); float* hid2 = (float*)(ws + WS_SMALL + 1 * MiB); float* sspart = (float*)(ws + WS_SMALL + 3 * MiB); float* sspart2 = (float*)(ws + WS_SMALL + 128 * 1024);
    bf16_t* abuf = (bf16_t*)(ws + WS_ABUF);
    bf16_t* x0T = (bf16_t*)(ws + WS_ABUF2); bf16_t* yaT = (bf16_t*)(ws + WS_ABUF2 + 16 * MiB); bf16_t* hb = (bf16_t*)(ws + WS_ABUF2);
    float* KT = (float*)(ws + WS_M); float* mbuf = (float*)(ws + WS_M);
    bf16_t* Z = (bf16_t*)(ws + WS_H); float* uT = (float*)(ws + WS_H + 96 * MiB); bf16_t* hmid = (bf16_t*)(ws + WS_H);
    float* xres = a.out;
    cg::grid_group grid = cg::this_grid();
    const int lo = a.ph_lo, hi = a.ph_hi;
#ifndef PHMASK
#define PHMASK 0xFFFF
#endif
#define IN(k) (((PHMASK >> (k)) & 1) && lo <= (k) && (k) < hi)
#define SEAM(k) do { if (IN(k) && IN((k) + 1)) { if (a.ph_hi > NPHASE) grid.sync(); xcd_barrier(xbar); } } while (0)
    {   volatile LAS unsigned* st = (volatile LAS unsigned*)(lds + FFT_LDS_BYTES);
        if (tid < 16) st[tid] = 0u;
        __syncthreads(); }
    const XcdBarrier xbar = xcd_barrier_post((unsigned*)(ws + WS_CTL), (volatile LAS unsigned*)(lds + FFT_LDS_BYTES));

    if (IN(0)) {
        LAS float* scr = (LAS float*)(lds + wave * 16640);
        constexpr int I_IN = 32 * 96, I_OUT = 32 * 32, I_1 = 32 * 128, I_2 = 128 * 32, I_P = 8 * 8;
        constexpr int NITEMS = I_IN + I_OUT + 2 * I_1 + 2 * I_2 + 4 * I_P;
        for (int it = gw; it < NITEMS; it += NGW) {
            int r = it;
            if (r < I_IN) { transpose_item(a.in[2], DIN, Wt_in, D, 0, norm_g + 0 * D, scr, r, lane); continue; } r -= I_IN;
            if (r < I_OUT) { transpose_item(a.in[14], D, Wt_out, D, 0, nullptr, scr, r, lane); continue; } r -= I_OUT;
            if (r < 2 * I_1) { const int l = r / I_1; transpose_item(a.in[17] + (size_t)l * D * DFF, DFF, Wt_1 + (size_t)l * DFF * D, D, 0, norm_g + (l * 4 + 2) * D, scr, r % I_1, lane, l == 1); continue; } r -= 2 * I_1;
            if (r < 2 * I_2) { const int l = r / I_2; transpose_item(a.in[18] + (size_t)l * DFF * D, D, Wt_2 + (size_t)l * D * DFF, DFF, 0, nullptr, scr, r % I_2, lane, l == 1); continue; } r -= 2 * I_2;
            { const int gq = r / I_P; transpose_item(a.in[15] + (size_t)gq * 512 * 512, 512, Wt_pool, 512, gq * 512, nullptr, scr, r % I_P, lane); }
        }
        for (int row = gw; row < L; row += NGW) {
            const f32x4* xr = (const f32x4*)(x + (size_t)row * D) + lane; u32x2* bo = (u32x2*)(abuf + (size_t)row * D) + lane; float ss = 0.f;
#pragma unroll
            for (int j = 0; j < 8; ++j) { const f32x4 v = __builtin_nontemporal_load(xr + 64 * j); ss += (v.x * v.x + v.y * v.y) + (v.z * v.z + v.w * v.w); bo[64 * j] = (u32x2){pk2(v.x, v.y), pk2(v.z, v.w)}; }
            const float r = rsqrtf(wave_sum(ss) * (1.0f / D) + 1e-6f);
            if (lane == 0) rA[row] = r;
        }
        {
            const float* w1 = a.in[5]; const float* b1 = a.in[6]; const float* w2 = a.in[7]; const float* b2 = a.in[8]; const float fr = a.in[11][lane];
            for (int t = gw; t < L; t += NGW) {
                const int e = lane; float val;
                {   const int b = (e >= 17) ? (e - 17) : (e - 1);
                    const float band = 1e-4f + (float)b * ((15.0f - 1e-4f) / 15.0f);
                    float rev = ((float)t * (1.0f / 8192.0f)) * band; rev -= floorf(rev);
                    val = (e == 0) ? (float)t * (1.0f / 8191.0f) : ((e <= 16) ? cos_rev(rev) : -sin_rev(rev)); }
                float z1 = b1[lane];
#pragma unroll
                for (int i = 0; i < 33; ++i) z1 += __int_as_float(__builtin_amdgcn_readlane(__float_as_int(val), i)) * w1[i * 64 + lane];
                const float h1 = sin_rev(fr * z1 * 0.15915494309189535f);
                float z2 = b2[lane];
#pragma unroll
                for (int i = 0; i < 64; ++i) z2 += __int_as_float(__builtin_amdgcn_readlane(__float_as_int(h1), i)) * w2[i * 64 + lane];
                hid2[(size_t)t * 64 + lane] = sin_rev(fr * z2 * 0.15915494309189535f);
            }
        }
    }
    SEAM(0);

    if (IN(1)) {
        {
            typedef float f32x16 __attribute__((ext_vector_type(16)));
            const float* w3 = a.in[9]; const float* b3 = a.in[10];
            const int cl = lane & 31, h = lane >> 5;
            auto split8 = [](const float (&v)[8], bf16x8& hi, bf16x8& lo) {
                u32x4 hw, lw; unsigned hh[4], ll[4];
#pragma unroll
                for (int i = 0; i < 4; ++i) { hh[i] = pk2(v[2 * i], v[2 * i + 1]); ll[i] = pk2(v[2 * i] - bf_lo(hh[i]), v[2 * i + 1] - bf_hi(hh[i])); }
                hw = (u32x4){hh[0], hh[1], hh[2], hh[3]}; lw = (u32x4){ll[0], ll[1], ll[2], ll[3]};
                hi = __builtin_bit_cast(bf16x8, hw); lo = __builtin_bit_cast(bf16x8, lw); };
            for (int it = gw; it < 64 * 64; it += NGW) {
                const int cb = it >> 6, tq = it & 63, c0 = cb * 32;
                bf16x8 ahi[4], alo[4];
#pragma unroll
                for (int sidx = 0; sidx < 4; ++sidx) { float av[8];
#pragma unroll
                    for (int e = 0; e < 8; ++e) av[e] = w3[(size_t)(16 * sidx + 8 * h + e) * 2048 + c0 + cl];
                    split8(av, ahi[sidx], alo[sidx]); }
                constexpr float DMIN = -3.0701134573253943f, DMAX = -15.350567286626972f;
#pragma unroll 1
                for (int q = 0; q < 4; ++q) {
                    const int tg = tq * 128 + q * 32 + cl;
                    f32x4 bv[8];
#pragma unroll
                    for (int i = 0; i < 8; ++i) bv[i] = *(const f32x4*)(hid2 + (size_t)tg * 64 + 16 * (i >> 1) + 8 * h + 4 * (i & 1));
                    f32x16 acc = {0.f, 0.f, 0.f, 0.f, 0.f, 0.f, 0.f, 0.f, 0.f, 0.f, 0.f, 0.f, 0.f, 0.f, 0.f, 0.f};
#pragma unroll
                    for (int sidx = 0; sidx < 4; ++sidx) { const float bvv[8] = {bv[2 * sidx].x, bv[2 * sidx].y, bv[2 * sidx].z, bv[2 * sidx].w, bv[2 * sidx + 1].x, bv[2 * sidx + 1].y, bv[2 * sidx + 1].z, bv[2 * sidx + 1].w};
                        bf16x8 bhi, blo; split8(bvv, bhi, blo);
                        acc = __builtin_amdgcn_mfma_f32_32x32x16_bf16(alo[sidx], bhi, acc, 0, 0, 0);
                        acc = __builtin_amdgcn_mfma_f32_32x32x16_bf16(ahi[sidx], blo, acc, 0, 0, 0);
                        acc = __builtin_amdgcn_mfma_f32_32x32x16_bf16(ahi[sidx], bhi, acc, 0, 0, 0); }
                    const float tl = (float)tg * (1.0f / 8191.0f);
                    int zoff = 0; asm volatile("" : "+v"(zoff));
#pragma unroll
                    for (int i = 0; i < 16; ++i) { const int c = c0 + 8 * (i >> 2) + 4 * h + (i & 3) + zoff, ch = c & 1023;
                        const float dlt = fabsf(DMIN + (float)ch * ((DMAX - DMIN) / 1023.0f));
                        const float val = (acc[i] + b3[c]) * __expf(-tl * dlt);
                        if (c < 1024) KT[(size_t)ch * NFFT + tg] = val;
                        else { if (tg >= 1) KT[(size_t)ch * NFFT + (NFFT - tg)] = val; else KT[(size_t)ch * NFFT + 8192] = 0.f; } }
                }
            }
        }
            { pg8::Gemm g{abuf, Wt_in, L, DIN, D, D, D, 0}; pg8::StaticOrder S; S.init(L, DIN, G, bid);
          pg8::EpiRowScaleBf16<false> E{Z, DIN, rA};
          f32x4 acc[2][2][4][2]; pg8::Unit cu; pg8::gemm_phase<pg8::EpiRowScaleBf16<false>, true>(lds, g, S, E, acc, cu); }
    }
    SEAM(1);

    if (IN(2)) {
        const float* hw = a.in[3]; const float* hbias = a.in[4]; const float* scw = a.in[13];
        bf16_t* ycat = abuf;
        LAS float* wl = (LAS float*)lds;
        LAS float* sbuf = (LAS float*)(lds + 4096);
        const int tt = tid >> 3, cg8 = tid & 7;
        const u32x4 zero4 = {0u, 0u, 0u, 0u};
        {
            u32x4 zr[3][3]; int cur_cb = -1, par = 0;
            auto issue = [&](int it) { const int tb = it >> 4, cb = it & 15, t = tb * 64 + tt, c8 = cb * 64 + cg8 * 8;
#pragma unroll
                for (int s3 = 0; s3 < 3; ++s3)
#pragma unroll
                    for (int d = 0; d < 3; ++d) { const int tr = t + d - 1; zr[s3][d] = (tr >= 0 && tr < L) ? *(const u32x4*)(Z + (size_t)tr * DIN + s3 * 1024 + c8) : zero4; } };
            if (bid < 2048) issue(bid);
            for (int it = bid; it < 2048; it += G, par ^= 1) {
                const int tb = it >> 4, cb = it & 15;
                if (cb != cur_cb) {
                    __syncthreads();
                    for (int i = tid; i < 768; i += 512) { const int rw = i >> 6, ch = i & 63, s3 = rw >> 2, k = rw & 3; wl[i] = (k < 3) ? hw[k * 3072 + s3 * 1024 + cb * 64 + ch] : hbias[s3 * 1024 + cb * 64 + ch]; }
                    __syncthreads(); cur_cb = cb; }
                float hy[3][8];
#pragma unroll
                for (int s3 = 0; s3 < 3; ++s3) { float zm[8], z0[8], zp[8]; unpack8(zr[s3][0], zm); unpack8(zr[s3][1], z0); unpack8(zr[s3][2], zp);
                    float w0[8], w1[8], w2[8], bb[8];
#pragma unroll
                    for (int hq = 0; hq < 2; ++hq) { const f32x4 a0 = *(LAS f32x4*)(wl + (4 * s3 + 0) * 64 + cg8 * 8 + 4 * hq), a1 = *(LAS f32x4*)(wl + (4 * s3 + 1) * 64 + cg8 * 8 + 4 * hq), a2 = *(LAS f32x4*)(wl + (4 * s3 + 2) * 64 + cg8 * 8 + 4 * hq), a3 = *(LAS f32x4*)(wl + (4 * s3 + 3) * 64 + cg8 * 8 + 4 * hq);
#pragma unroll
                        for (int j = 0; j < 4; ++j) { w0[4 * hq + j] = a0[j]; w1[4 * hq + j] = a1[j]; w2[4 * hq + j] = a2[j]; bb[4 * hq + j] = a3[j]; } }
#pragma unroll
                    for (int i = 0; i < 8; ++i) hy[s3][i] = w0[i] * zm[i] + w1[i] * z0[i] + w2[i] * zp[i] + bb[i]; }
                if (it + G < 2048) issue(it + G);
                LAS float* su = sbuf + par * (2 * 64 * 65); LAS float* sx = su + 64 * 65;
#pragma unroll
                for (int i = 0; i < 8; ++i) { su[(cg8 * 8 + i) * 65 + tt] = hy[2][i] * hy[1][i]; sx[(cg8 * 8 + i) * 65 + tt] = hy[0][i]; }
                __syncthreads();
                const int c = tid >> 3, ch = tid & 7;
                float uo[8], xo[8];
#pragma unroll
                for (int i = 0; i < 8; ++i) { uo[i] = su[c * 65 + ch * 8 + i]; xo[i] = sx[c * 65 + ch * 8 + i]; }
                float* up = uT + (size_t)(cb * 64 + c) * L + tb * 64 + ch * 8;
                *(f32x4*)up = (f32x4){uo[0], uo[1], uo[2], uo[3]}; *(f32x4*)(up + 4) = (f32x4){uo[4], uo[5], uo[6], uo[7]};
                *(u32x4*)(x0T + (size_t)(cb * 64 + c) * L + tb * 64 + ch * 8) = pack8(xo);
            }
        }
        {
            u32x4 rg, rc[3], rx[3];
            auto issue = [&](int it) { const int tb = it >> 4, cb = it & 15, t = tb * 64 + tt, c8 = cb * 64 + cg8 * 8;
                rg = *(const u32x4*)(Z + (size_t)t * DIN + 3072 + c8);
#pragma unroll
                for (int d = 0; d < 3; ++d) { const int tr = t + d - 1; const bool ok = (tr >= 0 && tr < L);
                    rc[d] = ok ? *(const u32x4*)(Z + (size_t)tr * DIN + 4096 + c8) : zero4; rx[d] = ok ? *(const u32x4*)(Z + (size_t)tr * DIN + 5120 + c8) : zero4; } };
            if (bid < 2048) issue(bid);
            for (int it = bid; it < 2048; it += G) {
                const int tb = it >> 4, cb = it & 15, t = tb * 64 + tt, c8 = cb * 64 + cg8 * 8;
                float gb[8], p[3][8];
                unpack8(rg, gb);
#pragma unroll
                for (int d = 0; d < 3; ++d) { float gc[8], xv[8]; unpack8(rc[d], gc); unpack8(rx[d], xv);
#pragma unroll
                    for (int i = 0; i < 8; ++i) p[d][i] = gc[i] * xv[i]; }
                if (it + G < 2048) issue(it + G);
                float yb[8];
#pragma unroll
                for (int i = 0; i < 8; ++i) yb[i] = gb[i] * (scw[c8 + i] * p[0][i] + scw[1024 + c8 + i] * p[1][i] + scw[2048 + c8 + i] * p[2][i]);
                *(u32x4*)(ycat + (size_t)t * D + 1024 + c8) = pack8(yb);
            }
        }
    }
    SEAM(2);

    if (IN(3)) {
        LAS cf* fa = (LAS cf*)lds; const float* hyb = a.in[12];
        f32x4 pkv[8], puv[4];
        if (bid < DHY) { const float* up0 = uT + (size_t)bid * L; const float* kp0 = KT + (size_t)bid * NFFT;
#pragma unroll
            for (int r = 0; r < 8; ++r) pkv[r] = __builtin_nontemporal_load((const f32x4*)(kp0 + 4 * (tid + 512 * r)));
#pragma unroll
            for (int r = 0; r < 4; ++r) puv[r] = *(const f32x4*)(up0 + 4 * (tid + 512 * r)); }
        cf Yr[16]; float Yh = 0.f; int kidx = 0;
        for (int c = bid; c < DHY; c += G, ++kidx) {
            const bool second = (kidx & 1) != 0, hold = (!second && (c + G < DHY));
            __syncthreads();
#pragma unroll
            for (int r = 0; r < 8; ++r) { const int n = 4 * (tid + 512 * r);
                const f32x4 kv = pkv[r]; const f32x4 uv = (r < 4) ? puv[r & 3] : (f32x4){0.f, 0.f, 0.f, 0.f};
                const int p = PADI(n);
                *(LAS f32x4*)(fa + p) = (f32x4){uv.x, kv.x, uv.y, kv.y}; *(LAS f32x4*)(fa + p + 2) = (f32x4){uv.z, kv.z, uv.w, kv.w}; }
            if (c + G < DHY) { const float* up1 = uT + (size_t)(c + G) * L; const float* kp1 = KT + (size_t)(c + G) * NFFT;
#pragma unroll
                for (int r = 0; r < 8; ++r) pkv[r] = __builtin_nontemporal_load((const f32x4*)(kp1 + 4 * (tid + 512 * r)));
#pragma unroll
                for (int r = 0; r < 4; ++r) puv[r] = *(const f32x4*)(up1 + 4 * (tid + 512 * r)); }
            __syncthreads();
            pass16<10, true>(fa, tid); __syncthreads();
            pass16<6, true>(fa, tid); __syncthreads();
            pass16<2, true>(fa, tid); __syncthreads();
            pass4<-1>(fa, tid); __syncthreads();
            {   const float sc = 0.25f / (float)NFFT;
#pragma unroll
                for (int r = 0; r < 16; ++r) { const int idx = tid + 512 * r;
                    const int f = (idx >> 9) + 16 * ((idx >> 5) & 15) + 256 * ((idx >> 1) & 15) + 4096 * (idx & 1);
                    const int fp = (NFFT - f) & (NFFT - 1);
                    const int p = PADI(fpos(f)), pp = PADI(fpos(fp));
                    const cf A = fa[p], Bc = fa[pp];
                    const float dx = (A.x * A.x - A.y * A.y) - (Bc.x * Bc.x - Bc.y * Bc.y), dy = 2.f * A.x * A.y + 2.f * Bc.x * Bc.y;
                    const cf Y = {dy * sc, -dx * sc};
                    if (hold) Yr[r] = Y;
                    else if (second) { const cf Y1 = Yr[r]; fa[p] = (cf){Y1.x - Y.y, Y1.y + Y.x}; fa[pp] = (cf){Y1.x + Y.y, Y.x - Y1.y}; }
                    else { fa[p] = Y; fa[pp] = (cf){Y.x, -Y.y}; } }
                if (tid == 0) { const int p = PADI(2); const cf A = fa[p]; const float yh = A.x * A.y * (1.0f / (float)NFFT);
                    if (hold) Yh = yh; else if (second) fa[p] = (cf){Yh, yh}; else fa[p] = (cf){yh, 0.f}; }
            }
            if (hold) continue;
            __syncthreads();
            pass4<1>(fa, tid); __syncthreads();
            pass16<2, false>(fa, tid); __syncthreads();
            pass16<6, false>(fa, tid); __syncthreads();
            const int c1 = second ? c - G : c;
            f32x4 ou0[2][2], ou1[2][2]; u32x4 ox0[2][2];
#pragma unroll
            for (int q = 0; q < 2; ++q) { const int cc = q ? c : c1;
#pragma unroll
                for (int r = 0; r < 2; ++r) { const int t0 = 8 * (tid + 512 * r); const float* upq = uT + (size_t)cc * L;
                    ou0[q][r] = *(const f32x4*)(upq + t0); ou1[q][r] = *(const f32x4*)(upq + t0 + 4); ox0[q][r] = *(const u32x4*)(x0T + (size_t)cc * L + t0); } }
            pass16<10, false>(fa, tid); __syncthreads();
#pragma unroll
            for (int q = 0; q < 2; ++q) { if (q == 1 && !second) break;
                const int cc = q ? c : c1; const float bias = hyb[cc];
#pragma unroll
                for (int r = 0; r < 2; ++r) { const int t0 = 8 * (tid + 512 * r); const int p = PADI(t0);
                    float y[8];
#pragma unroll
                    for (int i = 0; i < 4; ++i) { const f32x4 qv = *(LAS f32x4*)(fa + p + 2 * i); y[2 * i] = q ? qv.y : qv.x; y[2 * i + 1] = q ? qv.w : qv.z; }
                    float x0v[8]; unpack8(ox0[q][r], x0v);
                    const float uu[8] = {ou0[q][r].x, ou0[q][r].y, ou0[q][r].z, ou0[q][r].w, ou1[q][r].x, ou1[q][r].y, ou1[q][r].z, ou1[q][r].w};
                    float o[8];
#pragma unroll
                    for (int i = 0; i < 8; ++i) o[i] = x0v[i] * (y[i] + bias * uu[i]);
                    *(u32x4*)(yaT + (size_t)cc * L + t0) = pack8(o); } }
        }
    }
    SEAM(3);

    if (IN(4)) {
        bf16_t* ycat = abuf;
        for (int item = bid; item < 128 * 8; item += G) {
            const int tb = item >> 3, cb = item & 7, t0 = tb * 64 + wave * 8, c2 = cb * 128 + 2 * lane;
            const u32x4 ra = *(const u32x4*)(yaT + (size_t)c2 * L + t0), rb = *(const u32x4*)(yaT + (size_t)(c2 + 1) * L + t0);
            const unsigned wa[4] = {ra.x, ra.y, ra.z, ra.w}, wb[4] = {rb.x, rb.y, rb.z, rb.w};
#pragma unroll
            for (int i = 0; i < 4; ++i) {
                *(unsigned*)(ycat + (size_t)(t0 + 2 * i) * D + c2) = (wa[i] & 0xffffu) | (wb[i] << 16);
                *(unsigned*)(ycat + (size_t)(t0 + 2 * i + 1) * D + c2) = (wa[i] >> 16) | (wb[i] & 0xffff0000u); }
        }
    }
    SEAM(4);

    if (IN(5)) {
        pg8::Gemm g{abuf, Wt_out, L, D, D, D, D, 0}; pg8::StaticOrder S; S.init(L, D, G, bid);
        pg8::EpiRowScaleBf16<false> E{nullptr, D, nullptr};
        f32x4 acc[2][2][4][2]; pg8::Unit cu{0, 0}; const bool has = pg8::gemm_phase<pg8::EpiRowScaleBf16<false>, false, true>(lds, g, S, E, acc, cu);
        const FusedArgs F{x, xres, abuf, rA, norm_g + 1 * D, nullptr, nullptr, sspart, sspart2};
        fused_res_epilogue<0>(acc, has, cu, F, (LAS float*)lds, xbar, tid);
    }
    SEAM(5);
    if (IN(7)) {
        pg8::Gemm g{abuf, Wt_1, L, DFF, D, D, D, 0}; pg8::StaticOrder S; S.init(L, DFF, G, bid);
        pg8::EpiRowScaleBf16<true> E{hmid, DFF, rA};
        f32x4 acc[2][2][4][2]; pg8::Unit cu; pg8::gemm_phase<pg8::EpiRowScaleBf16<true>, true>(lds, g, S, E, acc, cu);
    }
    SEAM(7);
    if (IN(8)) {
        pg8::Gemm g{hmid, Wt_2, L, D, DFF, DFF, DFF, 0}; pg8::StaticOrder S; S.init(L, D, G, bid);
        pg8::EpiRowScaleBf16<false> E{nullptr, D, nullptr};
        f32x4 acc[2][2][4][2]; pg8::Unit cu{0, 0}; const bool has = pg8::gemm_phase<pg8::EpiRowScaleBf16<false>, false, true>(lds, g, S, E, acc, cu);
        const FusedArgs F{xres, xres, hb, nullptr, norm_g + 3 * D, norm_g + 4 * D, nullptr, sspart, sspart2};
        fused_res_epilogue<1>(acc, has, cu, F, (LAS float*)lds, xbar, tid);
    }
    SEAM(8);
    if (IN(10)) {
        const int chunk = tid & 255, c8 = chunk * 8, rsel = (tid >> 6) & 3;
        for (int it = bid * 2 + (tid >> 8); it < 1024; it += 2 * G) {
            const int t0 = it * 8;
            auto body = [&](auto RC) {
                constexpr int R = decltype(RC)::value;
                u32x4 rows[8 + 2 * R]; const u32x4 zero = {0u, 0u, 0u, 0u};
#pragma unroll
                for (int i = 0; i < 8 + 2 * R; ++i) { const int tr = t0 - R + i; rows[i] = (tr >= 0 && tr < L) ? *(const u32x4*)(hb + (size_t)tr * D + c8) : zero; }
                float S[8];
#pragma unroll
                for (int i = 0; i < 8; ++i) S[i] = 0.f;
#pragma unroll
                for (int j = 0; j < 2 * R + 1; ++j) { float v[8]; unpack8(rows[j], v);
#pragma unroll
                    for (int i = 0; i < 8; ++i) S[i] += v[i]; }
#pragma unroll
                for (int k = 0; k < 8; ++k) {
                    const int t = t0 + k, lo2 = max(t - R, 0), hi2 = min(t + R + 1, L); const float inv = 1.0f / (float)(hi2 - lo2);
                    float hv[8], o[8]; unpack8(rows[k + R], hv);
#pragma unroll
                    for (int i = 0; i < 8; ++i) o[i] = S[i] * inv - hv[i];
                    *(u32x4*)(abuf + (size_t)t * D + c8) = pack8(o);
                    if (k < 7) { float va[8], vs[8]; unpack8(rows[k + 2 * R + 1], va); unpack8(rows[k], vs);
#pragma unroll
                        for (int i = 0; i < 8; ++i) S[i] += va[i] - vs[i]; }
                }
            };
            if (rsel == 0) body(std::integral_constant<int, 1>{}); else if (rsel == 1) body(std::integral_constant<int, 2>{});
            else if (rsel == 2) body(std::integral_constant<int, 4>{}); else body(std::integral_constant<int, 8>{});
        }
    }
    SEAM(10);
    if (IN(11)) {
        pg8::Gemm g{abuf, Wt_pool, L, D, 512, D, 512, 512}; pg8::StaticOrder S; S.init(L, D, G, bid);
        pg8::EpiRowScaleBf16<false> E{nullptr, D, nullptr};
        f32x4 acc[2][2][4][2]; pg8::Unit cu{0, 0}; const bool has = pg8::gemm_phase<pg8::EpiRowScaleBf16<false>, false, true>(lds, g, S, E, acc, cu);
        const FusedArgs F{xres, xres, abuf, rA, norm_g + 5 * D, nullptr, a.in[16], sspart, sspart2};
        fused_res_epilogue<0>(acc, has, cu, F, (LAS float*)lds, xbar, tid);
    }
    SEAM(11);
    if (IN(13)) {
        pg8::Gemm g{abuf, Wt_1 + (size_t)DFF * D, L, DFF, D, D, D, 0}; pg8::StaticOrder S; S.init(L, DFF, G, bid);
        pg8::EpiRowScaleBf16<true> E{hmid, DFF, rA};
        f32x4 acc[2][2][4][2]; pg8::Unit cu; pg8::gemm_phase<pg8::EpiRowScaleBf16<true>, true>(lds, g, S, E, acc, cu);
    }
    SEAM(13);
    if (IN(14)) {
        pg8::Gemm g{hmid, Wt_2 + (size_t)D * DFF, L, D, DFF, DFF, DFF, 0}; pg8::StaticOrder S; S.init(L, D, G, bid);
        pg8::EpiRowScaleBf16<false> E{nullptr, D, nullptr};
        f32x4 acc[2][2][4][2]; pg8::Unit cu{0, 0}; const bool has = pg8::gemm_phase<pg8::EpiRowScaleBf16<false>, false, true>(lds, g, S, E, acc, cu);
        const FusedArgs F{xres, xres, nullptr, nullptr, norm_g + 7 * D, nullptr, nullptr, sspart, sspart2};
        fused_res_epilogue<2>(acc, has, cu, F, (LAS float*)lds, xbar, tid);
    }
}


extern "C" void kernel_launch(void* const* d_in, const int* in_sizes, int n_in, void* d_out, int out_size, void* d_ws, size_t ws_size, hipStream_t stream) {
    static int grid = 0;
    if (grid == 0) {
        if (n_in != 19 || out_size != L * D || ws_size < WS_END) { fprintf(stderr, "kernel_launch: unexpected shapes (n_in %d out %d ws %zu)\n", n_in, out_size, ws_size); grid = -1; return; }
        int dev = 0, cus = 0, per_cu = 0;
        hipGetDevice(&dev); hipDeviceGetAttribute(&cus, hipDeviceAttributeMultiprocessorCount, dev);
        if (hipFuncSetAttribute((const void*)fwd_kernel, hipFuncAttributeMaxDynamicSharedMemorySize, LDS_BYTES) != hipSuccess) { fprintf(stderr, "kernel_launch: hipFuncSetAttribute failed\n"); grid = -1; return; }
        if (hipOccupancyMaxActiveBlocksPerMultiprocessor(&per_cu, (const void*)fwd_kernel, 512, LDS_BYTES) != hipSuccess || per_cu < 1) { fprintf(stderr, "kernel_launch: occupancy query says %d\n", per_cu); per_cu = 1; }
        (void)hipGetLastError();
        grid = cus * per_cu;
        if (grid < 256) { fprintf(stderr, "kernel_launch: the fused GEMM epilogues need >= 256 co-resident workgroups, got %d\n", grid); grid = -1; return; }
    }
    if (grid < 0) return;
    if (hipMemsetAsync((char*)d_ws + WS_CTL, 0, CTL_BYTES, stream) != hipSuccess) { fprintf(stderr, "kernel_launch: memset failed\n"); return; }
    Args a{};
    for (int i = 0; i < 19; ++i) a.in[i] = (const float*)d_in[i];
    a.out = (float*)d_out; a.ws = (unsigned char*)d_ws;
    a.ph_lo = 0; a.ph_hi = NPHASE;
    void* args[] = {&a};
    hipError_t e = hipLaunchCooperativeKernel((const void*)fwd_kernel, dim3(grid), dim3(512), args, LDS_BYTES, stream);
    if (e != hipSuccess) fprintf(stderr, "cooperative launch failed: %s (grid %d)\n", hipGetErrorString(e), grid);
}
```
